# Optimizing an MI355X kernel written in HIP

```python
import math
import jax
import jax.numpy as jnp
from jax import lax
import numpy as np

D_MODEL = 2048
BATCH = 4
SEQ = 4096
DEPTH = 2

GRID_W = 64
N_HEADS = 16
HEAD_DIM = D_MODEL // N_HEADS
WIN_H = 8
WIN_W = 16
S5_GROUP = 16
S5_GROUPS = D_MODEL // S5_GROUP
S5_STATE = 64
D_FF = ((8 * D_MODEL // 3 + 127) // 128) * 128
N_MIXERS = 2
N_A = (DEPTH + 1) // 2
N_B = DEPTH // 2
ALPHA = (2 * DEPTH) ** 0.25
BETA = (8 * DEPTH) ** -0.25
LN_EPS = 1e-5
MIN_NEG_RE = -1e-4

kernel_name = "hybrid_s5_natten_macaron_deepnorm"


def layer_norm(x, g, b):
    xf = x.astype(jnp.float32)
    mu = jnp.mean(xf, axis=-1, keepdims=True)
    xc = xf - mu
    var = jnp.mean(xc * xc, axis=-1, keepdims=True)
    y = xc * lax.rsqrt(var + LN_EPS) * g.astype(jnp.float32) + b.astype(jnp.float32)
    return y.astype(x.dtype)


def swiglu(x, w_gate, w_up, w_down):
    return (jax.nn.silu(x @ w_gate) * (x @ w_up)) @ w_down


def _complex_combine(left, right):
    a1r, a1i, b1r, b1i = left
    a2r, a2i, b2r, b2i = right
    ar = a2r * a1r - a2i * a1i
    ai = a2r * a1i + a2i * a1r
    br = a2r * b1r - a2i * b1i + b2r
    bi = a2r * b1i + a2i * b1r + b2i
    return (ar, ai, br, bi)


def s5_direction(u, lam_re, lam_im, log_dt, b_re, b_im, c_re, c_im, reverse):
    L = u.shape[1]
    lr = jnp.minimum(lam_re.astype(jnp.float32), MIN_NEG_RE)
    li = lam_im.astype(jnp.float32)
    dt = jnp.exp(log_dt.astype(jnp.float32))[:, None]
    mag = jnp.exp(lr * dt)
    lb_re = mag * jnp.cos(li * dt)
    lb_im = mag * jnp.sin(li * dt)
    den = lr * lr + li * li
    nr = lb_re - 1.0
    ni = lb_im
    f_re = (nr * lr + ni * li) / den
    f_im = (ni * lr - nr * li) / den
    br = b_re.astype(jnp.float32)
    bi = b_im.astype(jnp.float32)
    bb_re = f_re[:, :, None] * br - f_im[:, :, None] * bi
    bb_im = f_re[:, :, None] * bi + f_im[:, :, None] * br
    bu_re = jnp.einsum('blgc,gpc->blgp', u, bb_re)
    bu_im = jnp.einsum('blgc,gpc->blgp', u, bb_im)
    a_re = jnp.broadcast_to(lb_re[None, None], (1, L) + lb_re.shape)
    a_im = jnp.broadcast_to(lb_im[None, None], (1, L) + lb_im.shape)
    _, _, s_re, s_im = lax.associative_scan(
        _complex_combine, (a_re, a_im, bu_re, bu_im), reverse=reverse, axis=1)
    return (jnp.einsum('blgp,gcp->blgc', s_re, c_re.astype(jnp.float32))
            - jnp.einsum('blgp,gcp->blgc', s_im, c_im.astype(jnp.float32)))


def s5_mixer(x, lam_re, lam_im, log_dt, b_re, b_im, c_re, c_im, d_skip, w_val, w_gate):
    Bsz, L, D = x.shape
    u = x.astype(jnp.float32).reshape(Bsz, L, S5_GROUPS, S5_GROUP)
    y_f = s5_direction(u, lam_re[0], lam_im[0], log_dt[0], b_re[0], b_im[0],
                       c_re[0], c_im[0], reverse=False)
    y_b = s5_direction(u, lam_re[1], lam_im[1], log_dt[1], b_re[1], b_im[1],
                       c_re[1], c_im[1], reverse=True)
    y = (y_f + y_b).reshape(Bsz, L, D) + d_skip.astype(jnp.float32) * x.astype(jnp.float32)
    g = jax.nn.gelu(y).astype(x.dtype)
    return (g @ w_val) * jax.nn.sigmoid(g @ w_gate)


def natten_mixer(x, w_qkv, rpb, w_out):
    Bsz, L, D = x.shape
    rows = L // GRID_W
    kh = min(WIN_H, rows)
    qkv = (x @ w_qkv).reshape(Bsz, rows, GRID_W, 3, N_HEADS, HEAD_DIM)
    q = qkv[:, :, :, 0] * (HEAD_DIM ** -0.5)
    k = qkv[:, :, :, 1]
    v = qkv[:, :, :, 2]
    cols = np.arange(GRID_W)
    col_start = np.clip(cols - WIN_W // 2, 0, GRID_W - WIN_W)
    col_idx = col_start[:, None] + np.arange(WIN_W)[None, :]
    col_off = col_idx - cols[:, None] + (WIN_W - 1)
    win_rows = jnp.arange(kh)

    def one_row(r):
        rs = jnp.clip(r - kh // 2, 0, rows - kh)
        k_rows = lax.dynamic_slice_in_dim(k, rs, kh, axis=1)
        v_rows = lax.dynamic_slice_in_dim(v, rs, kh, axis=1)
        k_win = k_rows[:, :, col_idx]
        v_win = v_rows[:, :, col_idx]
        q_r = lax.dynamic_index_in_dim(q, r, axis=1, keepdims=False)
        s = jnp.einsum('bchd,bicjhd->bhcij', q_r, k_win).astype(jnp.float32)
        row_off = rs + win_rows - r + (WIN_H - 1)
        bias = rpb[:, row_off][:, :, col_off]
        s = s + jnp.transpose(bias, (0, 2, 1, 3)).astype(jnp.float32)[None]
        p = jax.nn.softmax(s.reshape(Bsz, N_HEADS, GRID_W, kh * WIN_W), axis=-1)
        p = p.reshape(Bsz, N_HEADS, GRID_W, kh, WIN_W).astype(v.dtype)
        return jnp.einsum('bhcij,bicjhd->bchd', p, v_win)

    out = lax.map(one_row, jnp.arange(rows))
    out = jnp.moveaxis(out, 0, 1).reshape(Bsz, L, D)
    return out @ w_out


def setup_inputs(seed: int = 0) -> dict:
    key = jax.random.key(seed)
    ks = jax.random.split(key, 20)
    D, F, G, P, GC = D_MODEL, D_FF, S5_GROUPS, S5_STATE, S5_GROUP
    x = jax.random.normal(ks[0], (BATCH, SEQ, D), jnp.float32)
    ffn_w_gate = jax.random.normal(ks[1], (DEPTH, 2, D, F), jnp.float32) * D ** -0.5
    ffn_w_up = jax.random.normal(ks[2], (DEPTH, 2, D, F), jnp.float32) * D ** -0.5
    ffn_w_down = jax.random.normal(ks[3], (DEPTH, 2, F, D), jnp.float32) * (F ** -0.5 * BETA)
    ln_g = 1.0 + 0.02 * jax.random.normal(ks[4], (DEPTH, 3, D), jnp.float32)
    ln_b = 0.02 * jax.random.normal(ks[5], (DEPTH, 3, D), jnp.float32)
    s5_lam_re = -0.5 + 0.01 * jax.random.normal(ks[6], (N_A, 2, G, P), jnp.float32)
    n_idx = jnp.arange(P, dtype=jnp.float32)
    s5_lam_im = math.pi * n_idx + 0.01 * jax.random.normal(ks[7], (N_A, 2, G, P), jnp.float32)
    s5_log_dt = jax.random.uniform(ks[8], (N_A, 2, G), jnp.float32,
                                   minval=math.log(1e-3), maxval=math.log(1e-1))
    s5_b_re = jax.random.normal(ks[9], (N_A, 2, G, P, GC), jnp.float32) * (2 * GC) ** -0.5
    s5_b_im = jax.random.normal(ks[10], (N_A, 2, G, P, GC), jnp.float32) * (2 * GC) ** -0.5
    s5_c_re = jax.random.normal(ks[11], (N_A, 2, G, GC, P), jnp.float32) * (2 * P) ** -0.5
    s5_c_im = jax.random.normal(ks[12], (N_A, 2, G, GC, P), jnp.float32) * (2 * P) ** -0.5
    s5_d = jax.random.normal(ks[13], (N_A, D), jnp.float32)
    s5_w_glu_val = jax.random.normal(ks[14], (N_A, D, D), jnp.float32) * (D ** -0.5 * BETA)
    s5_w_glu_gate = jax.random.normal(ks[15], (N_A, D, D), jnp.float32) * D ** -0.5
    na_w_qkv = jax.random.normal(ks[16], (N_B, D, 3 * D), jnp.float32) * D ** -0.5
    na_rpb = 0.02 * jax.random.normal(ks[17], (N_B, N_HEADS, 2 * WIN_H - 1, 2 * WIN_W - 1), jnp.float32)
    na_w_out = jax.random.normal(ks[18], (N_B, D, D), jnp.float32) * (D ** -0.5 * BETA)
    return {"x": x, "ffn_w_gate": ffn_w_gate, "ffn_w_up": ffn_w_up, "ffn_w_down": ffn_w_down,
            "ln_g": ln_g, "ln_b": ln_b,
            "s5_lam_re": s5_lam_re, "s5_lam_im": s5_lam_im, "s5_log_dt": s5_log_dt,
            "s5_b_re": s5_b_re, "s5_b_im": s5_b_im, "s5_c_re": s5_c_re, "s5_c_im": s5_c_im,
            "s5_d": s5_d, "s5_w_glu_val": s5_w_glu_val, "s5_w_glu_gate": s5_w_glu_gate,
            "na_w_qkv": na_w_qkv, "na_rpb": na_rpb, "na_w_out": na_w_out}


def reference(x, ffn_w_gate, ffn_w_up, ffn_w_down, ln_g, ln_b,
              s5_lam_re, s5_lam_im, s5_log_dt, s5_b_re, s5_b_im, s5_c_re, s5_c_im,
              s5_d, s5_w_glu_val, s5_w_glu_gate, na_w_qkv, na_rpb, na_w_out):
    for i in range(DEPTH):
        f1 = swiglu(x, ffn_w_gate[i, 0], ffn_w_up[i, 0], ffn_w_down[i, 0])
        x = layer_norm(ALPHA * x + 0.5 * f1, ln_g[i, 0], ln_b[i, 0])
        j = i // N_MIXERS
        if i % N_MIXERS == 0:
            m = s5_mixer(x, s5_lam_re[j], s5_lam_im[j], s5_log_dt[j], s5_b_re[j], s5_b_im[j],
                         s5_c_re[j], s5_c_im[j], s5_d[j], s5_w_glu_val[j], s5_w_glu_gate[j])
        else:
            m = natten_mixer(x, na_w_qkv[j], na_rpb[j], na_w_out[j])
        x = layer_norm(ALPHA * x + m, ln_g[i, 1], ln_b[i, 1])
        f2 = swiglu(x, ffn_w_gate[i, 1], ffn_w_up[i, 1], ffn_w_down[i, 1])
        x = layer_norm(ALPHA * x + 0.5 * f2, ln_g[i, 2], ln_b[i, 2])
    return x
```

```cpp
#include <hip/hip_runtime.h>
#include <hip/hip_cooperative_groups.h>
#include <cstdio>
#include <cstdint>
namespace cg = cooperative_groups;
namespace pg8 {
#define PG8_LAS __attribute__((address_space(3)))
typedef unsigned short bf16_t;
typedef short bf16x8 __attribute__((ext_vector_type(8)));
typedef float f32x4 __attribute__((ext_vector_type(4)));
typedef unsigned u32x4 __attribute__((ext_vector_type(4)));
constexpr int BM = 256, BK = 64, HALF = 128, HTB = HALF * BK * 2  , STAGE_BYTES = 8 * HTB, NXCD = 8, WGM = 8;

__host__ __device__ __forceinline__ int lds_byte(int r, int c) { const int st = (r >> 4) * 2 + (c >> 5), rr = r & 15, cc = c & 31, ob = rr * 64 + cc * 2; return st * 1024 + (ob ^ (((ob >> 9) & 1) << 5)); }
__host__ __device__ __forceinline__ void stage_rc(int b, int& R, int& C) { const int st = b / 1024, sb = b % 1024, swz = sb ^ (((sb >> 9) & 1) << 5); R = (st >> 1) * 16 + swz / 64; C = (st & 1) * 32 + (swz % 64) / 2; }
__host__ __device__ __forceinline__ int perm32(int rho) { const int n = rho >> 4, i = rho & 15; return 8 * (i >> 2) + 4 * n + (i & 3); }

struct Unit { int pm, pn; };
struct Gemm { const bf16_t* A; const bf16_t* Bt; int M, N, K; };

struct StaticOrder {
    int nM, nN, nwg, G, c;
    __host__ __device__ void init(int M, int N, int G_, int c_) { nM = M / BM; nN = N / BM; nwg = nM * nN; G = G_; c = c_; }
    __host__ __device__ bool next(int i, Unit& u) const {
        const long L = (long)i * G + c; if (L >= nwg) return false;
        int wgid = (int)L; { const int q = nwg / NXCD, r = nwg % NXCD, xcd = wgid % NXCD, off = wgid / NXCD; wgid = (xcd < r ? xcd * (q + 1) : r * (q + 1) + (xcd - r) * q) + off; }
        const int nig = WGM * nN, gid = wgid / nig, fm = gid * WGM, gsz = (nM - fm) < WGM ? (nM - fm) : WGM;
        u.pm = fm + ((wgid % nig) % gsz); u.pn = (wgid % nig) / gsz; return true;
    }
    __device__ __forceinline__ void a_ready(const Unit&) const {}
    __device__ __forceinline__ void done(const Unit&) const {}
};

__device__ __forceinline__ unsigned cvt_pk_bf16(float lo, float hi) { unsigned r; asm volatile("v_cvt_pk_bf16_f32 %0, %1, %2" : "=v"(r) : "v"(lo), "v"(hi)); return r; }
__device__ __forceinline__ float fast_sigmoid(float v) { return __builtin_amdgcn_rcpf(1.0f + __expf(-v)); }
constexpr float ALPHA_RES = 1.41421356237309515f;

struct EpiSwiGLU {
    static constexpr bool PERM = true, AFTER_DRAIN = false, SWAP = false;
    bf16_t* H; int ldh;
    __device__ __forceinline__ void operator()(const f32x4 (&acc)[2][2][4][2], const Unit& u, int wr, int wc, int fr, int fq) const {
        const int row0 = u.pm * BM + wr * 64 + fr, col0 = u.pn * HALF + wc * 32 + 8 * fq;
#pragma unroll
        for (int ai = 0; ai < 2; ++ai)
#pragma unroll
            for (int m = 0; m < 4; ++m) {
                bf16_t* rowp = H + (size_t)(row0 + ai * HALF + m * 16) * ldh + col0;
                float o[8];
#pragma unroll
                for (int n = 0; n < 2; ++n)
#pragma unroll
                    for (int e = 0; e < 4; ++e) { const float g = acc[ai][0][m][n][e], up = acc[ai][1][m][n][e]; o[4 * n + e] = g * fast_sigmoid(g) * up; }
                u32x4 w; w.x = cvt_pk_bf16(o[0], o[1]); w.y = cvt_pk_bf16(o[2], o[3]); w.z = cvt_pk_bf16(o[4], o[5]); w.w = cvt_pk_bf16(o[6], o[7]);
                *(u32x4*)rowp = w;
                asm volatile("" ::: "memory");
            }
    }
};
struct EpiResid {
    static constexpr bool PERM = true, AFTER_DRAIN = false, SWAP = false;
    const float* xin; float* Y; float scale;
    __device__ __forceinline__ void operator()(const f32x4 (&acc)[2][2][4][2], const Unit& u, int wr, int wc, int fr, int fq) const {
        const int row0 = u.pm * BM + wr * 64 + fr, col0 = u.pn * BM + wc * 32 + 8 * fq;
#pragma unroll
        for (int ai = 0; ai < 2; ++ai)
#pragma unroll
            for (int m = 0; m < 4; ++m) {
                const size_t off = (size_t)(row0 + ai * HALF + m * 16) * 2048 + col0;
#pragma unroll
                for (int bj = 0; bj < 2; ++bj)
#pragma unroll
                    for (int n = 0; n < 2; ++n) { const f32x4 xv = *(const f32x4*)(xin + off + bj * HALF + 4 * n);
                        *(f32x4*)(Y + off + bj * HALF + 4 * n) = xv * ALPHA_RES + acc[ai][bj][m][n] * scale; }
                asm volatile("" ::: "memory");
            }
    }
};
struct EpiGLU {
    static constexpr bool PERM = true, AFTER_DRAIN = false, SWAP = false;
    const float* xin; float* Y;
    __device__ __forceinline__ void operator()(const f32x4 (&acc)[2][2][4][2], const Unit& u, int wr, int wc, int fr, int fq) const {
        const int row0 = u.pm * BM + wr * 64 + fr, col0 = u.pn * HALF + wc * 32 + 8 * fq;
#pragma unroll
        for (int ai = 0; ai < 2; ++ai)
#pragma unroll
            for (int m = 0; m < 4; ++m) {
                const size_t off = (size_t)(row0 + ai * HALF + m * 16) * 2048 + col0;
#pragma unroll
                for (int n = 0; n < 2; ++n) { const f32x4 xv = *(const f32x4*)(xin + off + 4 * n); f32x4 o;
#pragma unroll
                    for (int e = 0; e < 4; ++e) o[e] = xv[e] * ALPHA_RES + acc[ai][0][m][n][e] * fast_sigmoid(acc[ai][1][m][n][e]);
                    *(f32x4*)(Y + off + 4 * n) = o; }
                asm volatile("" ::: "memory");
            }
    }
};
struct EpiQK {
    static constexpr bool PERM = true, AFTER_DRAIN = false, SWAP = false;
    bf16_t* Q; bf16_t* K; float qscale;
    __device__ __forceinline__ void operator()(const f32x4 (&acc)[2][2][4][2], const Unit& u, int wr, int wc, int fr, int fq) const {
        const int row0 = u.pm * BM + wr * 64 + fr; int colt = u.pn * BM; bf16_t* base = Q; float sc = qscale;
        if (colt >= 2048) { colt -= 2048; base = K; sc = 1.0f; }
        const int col0 = colt + wc * 32 + 8 * fq;
#pragma unroll
        for (int ai = 0; ai < 2; ++ai)
#pragma unroll
            for (int m = 0; m < 4; ++m) {
                bf16_t* rowp = base + (size_t)(row0 + ai * HALF + m * 16) * 2048 + col0;
#pragma unroll
                for (int bj = 0; bj < 2; ++bj) { const f32x4 v0 = acc[ai][bj][m][0] * sc, v1 = acc[ai][bj][m][1] * sc;
                    u32x4 w; w.x = cvt_pk_bf16(v0[0], v0[1]); w.y = cvt_pk_bf16(v0[2], v0[3]); w.z = cvt_pk_bf16(v1[0], v1[1]); w.w = cvt_pk_bf16(v1[2], v1[3]);
                    *(u32x4*)(rowp + bj * HALF) = w; }
            }
    }
};
struct EpiVT {
    static constexpr bool PERM = false, AFTER_DRAIN = false, SWAP = true;
    bf16_t* VT;
    __device__ __forceinline__ void operator()(const f32x4 (&acc)[2][2][4][2], const Unit& u, int wr, int wc, int fr, int fq) const {
        typedef unsigned u32x2 __attribute__((ext_vector_type(2)));
        const int tok0 = u.pm * BM + wr * 64 + 4 * fq, col0 = u.pn * BM + wc * 32 + fr;
#pragma unroll
        for (int bj = 0; bj < 2; ++bj)
#pragma unroll
            for (int n = 0; n < 2; ++n) {
                bf16_t* cp = VT + (size_t)(col0 + bj * HALF + n * 16) * 16384 + tok0;
#pragma unroll
                for (int ai = 0; ai < 2; ++ai)
#pragma unroll
                    for (int m = 0; m < 4; ++m) { const f32x4 v = acc[ai][bj][m][n]; u32x2 w; w.x = cvt_pk_bf16(v[0], v[1]); w.y = cvt_pk_bf16(v[2], v[3]);
                        *(u32x2*)(cp + ai * HALF + m * 16) = w; }
            }
    }
};


template <class Epi, class Sched, bool ALIGN_EPI = false, bool SP2 = false>
__device__ __forceinline__ void gemm_phase(PG8_LAS unsigned char* lds, const Gemm g, const Sched& S, const Epi& E) {
    int tid_opaque = threadIdx.x; asm volatile("" : "+v"(tid_opaque));
    const int tid = tid_opaque, wid = __builtin_amdgcn_readfirstlane(tid >> 6), lane = tid & 63, wr = wid >> 2, wc = wid & 3, fr = lane & 15, fq = lane >> 4;
    const int K = g.K, nt = K / BK;
    unsigned voffA[2], voffB[2];
#pragma unroll
    for (int i = 0; i < 2; ++i) { int R, C; stage_rc(tid * 16 + i * 8192, R, C); const int Rb = Epi::PERM ? ((R & ~31) + perm32(R & 31)) : R;
        voffA[i] = (unsigned)(R * K + C) * 2u; voffB[i] = (unsigned)(Rb * K + C) * 2u; }
    const size_t kstep = (size_t)(BK * 2);
    const size_t hstep = (size_t)HALF * K * 2;
    const size_t tstep = 2 * hstep;
    const unsigned ldsw = (unsigned)wid * 1024u;
    const int aoff = lds_byte(wr * 64 + fr, fq * 8), boff = lds_byte(wc * 32 + fr, fq * 8);
#define PG8_SA(b, h) (((b) * 2 + (h)) * HTB)
#define PG8_SB(b, h) ((4 + (b) * 2 + (h)) * HTB)
#define PG8_STAGE(bufoff, gbase, voff) do { _Pragma("unroll") for (int _i = 0; _i < 2; ++_i) \
        __builtin_amdgcn_global_load_lds((const unsigned*)((const char*)(gbase) + (voff)[_i]), (PG8_LAS unsigned*)(lds + (bufoff) + ldsw + _i * 8192), 16, 0, 0); } while (0)
#define PG8_LDA(dst, b, h) do { _Pragma("unroll") for (int m = 0; m < 4; ++m) _Pragma("unroll") for (int k = 0; k < 2; ++k) dst[m][k] = *(const PG8_LAS bf16x8*)(lds + PG8_SA(b, h) + aoff + m * 2048 + k * 1024); } while (0)
#define PG8_LDB(dst, b, h) do { _Pragma("unroll") for (int n = 0; n < 2; ++n) _Pragma("unroll") for (int k = 0; k < 2; ++k) dst[n][k] = *(const PG8_LAS bf16x8*)(lds + PG8_SB(b, h) + boff + n * 2048 + k * 1024); } while (0)
#define PG8_MMA(ai, bj, At, Bt) do { __builtin_amdgcn_s_setprio(1); _Pragma("unroll") for (int m = 0; m < 4; ++m) _Pragma("unroll") for (int n = 0; n < 2; ++n) _Pragma("unroll") for (int k = 0; k < 2; ++k) \
        acc[ai][bj][m][n] = Epi::SWAP ? __builtin_amdgcn_mfma_f32_16x16x32_bf16(At[m][k], Bt[n][k], acc[ai][bj][m][n], 0, 0, 0) : __builtin_amdgcn_mfma_f32_16x16x32_bf16(Bt[n][k], At[m][k], acc[ai][bj][m][n], 0, 0, 0); __builtin_amdgcn_s_setprio(0); } while (0)
#define PG8_WAIT_V(n) asm volatile("s_waitcnt vmcnt(" #n ")" ::: "memory")
#define PG8_WAIT_L(n) asm volatile("s_waitcnt lgkmcnt(" #n ")" ::: "memory")
#define PG8_BAR __builtin_amdgcn_s_barrier()
#define PG8_SCHED __builtin_amdgcn_sched_barrier(0)
    Unit cur, nxt; int ui = 0;
    if (!S.next(0, cur)) return;
    f32x4 acc[2][2][4][2];
#pragma unroll
    for (int a = 0; a < 2; ++a)
#pragma unroll
        for (int b = 0; b < 2; ++b)
#pragma unroll
            for (int m = 0; m < 4; ++m)
#pragma unroll
                for (int n = 0; n < 2; ++n) acc[a][b][m][n] = (f32x4){0.f, 0.f, 0.f, 0.f};
    bf16x8 At[4][2], B0[2][2], B1[2][2];
    const char* cA = (const char*)g.A + (size_t)cur.pm * tstep; const char* cB = (const char*)g.Bt + (size_t)cur.pn * tstep;
    S.a_ready(cur);
    if constexpr (SP2) {
        PG8_STAGE(PG8_SB(0, 0), cB, voffB); PG8_STAGE(PG8_SB(0, 1), cB + hstep, voffB); PG8_STAGE(PG8_SA(0, 0), cA, voffA); PG8_STAGE(PG8_SA(0, 1), cA + hstep, voffA);
        if (wr == 1) PG8_BAR;
        PG8_WAIT_V(2); PG8_BAR;
        PG8_STAGE(PG8_SB(1, 0), cB + kstep, voffB); PG8_STAGE(PG8_SA(1, 0), cA + kstep, voffA); PG8_STAGE(PG8_SB(1, 1), cB + hstep + kstep, voffB);
        PG8_WAIT_V(6); PG8_BAR;
    } else {
        PG8_STAGE(PG8_SB(0, 0), cB, voffB); PG8_STAGE(PG8_SA(0, 0), cA, voffA); PG8_STAGE(PG8_SB(0, 1), cB + hstep, voffB); PG8_STAGE(PG8_SA(0, 1), cA + hstep, voffA);
        if (wr == 1) PG8_BAR;
        PG8_WAIT_V(4); PG8_BAR;
        PG8_STAGE(PG8_SB(1, 0), cB + kstep, voffB); PG8_STAGE(PG8_SA(1, 0), cA + kstep, voffA); PG8_STAGE(PG8_SB(1, 1), cB + hstep + kstep, voffB);
        PG8_WAIT_V(6); PG8_BAR;
    }
    for (;;) {
        const bool has_next = S.next(ui + 1, nxt);
        const char* nA = has_next ? (const char*)g.A + (size_t)nxt.pm * tstep : cA; const char* nB = has_next ? (const char*)g.Bt + (size_t)nxt.pn * tstep : cB;
        for (int t = 0; t < nt; t += 2) {
            const bool last = (t == nt - 2);
            const char* a1 = cA + (size_t)(t + 1) * kstep;
            const char* a2 = last ? nA : cA + (size_t)(t + 2) * kstep; const char* b2 = last ? nB : cB + (size_t)(t + 2) * kstep;
            const char* a3 = a2 + kstep; const char* b3 = b2 + kstep;
            if (last && has_next) S.a_ready(nxt);
            if constexpr (SP2) {
            PG8_LDB(B0, 0, 0); PG8_LDB(B1, 0, 1); PG8_SCHED; PG8_LDA(At, 0, 0); PG8_STAGE(PG8_SA(1, 1), a1 + hstep, voffA);
            PG8_WAIT_V(8); PG8_WAIT_L(0); PG8_BAR; PG8_MMA(0, 0, At, B0); PG8_MMA(0, 1, At, B1); PG8_BAR; PG8_SCHED;
            PG8_LDA(At, 0, 1); PG8_STAGE(PG8_SB(0, 0), b2, voffB); PG8_STAGE(PG8_SB(0, 1), b2 + hstep, voffB); PG8_STAGE(PG8_SA(0, 0), a2, voffA);
            PG8_WAIT_V(8); PG8_WAIT_L(0); PG8_BAR; PG8_MMA(1, 0, At, B0); PG8_MMA(1, 1, At, B1); PG8_BAR; PG8_SCHED;
            PG8_LDB(B0, 1, 0); PG8_LDB(B1, 1, 1); PG8_SCHED; PG8_LDA(At, 1, 0); PG8_STAGE(PG8_SA(0, 1), a2 + hstep, voffA);
            PG8_WAIT_V(8); PG8_WAIT_L(0); PG8_BAR; PG8_MMA(0, 0, At, B0); PG8_MMA(0, 1, At, B1); PG8_BAR; PG8_SCHED;
            PG8_LDA(At, 1, 1); PG8_STAGE(PG8_SB(1, 0), b3, voffB); PG8_STAGE(PG8_SB(1, 1), b3 + hstep, voffB); PG8_STAGE(PG8_SA(1, 0), a3, voffA);
            PG8_WAIT_V(8); PG8_WAIT_L(0); PG8_BAR; PG8_MMA(1, 0, At, B0); PG8_MMA(1, 1, At, B1); PG8_BAR; PG8_SCHED;
            } else {
            PG8_LDB(B0, 0, 0); PG8_SCHED; PG8_LDA(At, 0, 0); PG8_STAGE(PG8_SA(1, 1), a1 + hstep, voffA);
            PG8_WAIT_L(8); PG8_BAR; PG8_WAIT_L(0); PG8_MMA(0, 0, At, B0); PG8_BAR; PG8_SCHED;
            PG8_LDB(B1, 0, 1); PG8_STAGE(PG8_SB(0, 0), b2, voffB);
            PG8_BAR; PG8_WAIT_L(0); PG8_MMA(0, 1, At, B1); PG8_BAR;
            PG8_LDA(At, 0, 1); PG8_STAGE(PG8_SA(0, 0), a2, voffA);
            PG8_BAR; PG8_WAIT_L(0); PG8_MMA(1, 0, At, B0); PG8_BAR; PG8_SCHED;
            PG8_STAGE(PG8_SB(0, 1), b2 + hstep, voffB);
            PG8_WAIT_V(6); PG8_BAR; PG8_MMA(1, 1, At, B1); PG8_BAR;
            PG8_LDB(B0, 1, 0); PG8_SCHED; PG8_LDA(At, 1, 0); PG8_STAGE(PG8_SA(0, 1), a2 + hstep, voffA);
            PG8_WAIT_L(8); PG8_BAR; PG8_WAIT_L(0); PG8_MMA(0, 0, At, B0); PG8_BAR; PG8_SCHED;
            PG8_LDB(B1, 1, 1); PG8_STAGE(PG8_SB(1, 0), b3, voffB);
            PG8_BAR; PG8_WAIT_L(0); PG8_MMA(0, 1, At, B1); PG8_BAR;
            PG8_LDA(At, 1, 1); PG8_STAGE(PG8_SA(1, 0), a3, voffA);
            PG8_BAR; PG8_WAIT_L(0); PG8_MMA(1, 0, At, B0); PG8_BAR; PG8_SCHED;
            PG8_STAGE(PG8_SB(1, 1), b3 + hstep, voffB);
            PG8_WAIT_V(6); PG8_BAR; PG8_MMA(1, 1, At, B1); PG8_BAR;
            }
        }
        if constexpr (ALIGN_EPI) { if (wr == 0) PG8_BAR; }
        if constexpr (!Epi::AFTER_DRAIN) { E(acc, cur, wr, wc, fr, fq); S.done(cur); }
        if (!has_next) break;
#pragma unroll
        for (int a = 0; a < 2; ++a)
#pragma unroll
            for (int b = 0; b < 2; ++b)
#pragma unroll
                for (int m = 0; m < 4; ++m)
#pragma unroll
                    for (int n = 0; n < 2; ++n) acc[a][b][m][n] = (f32x4){0.f, 0.f, 0.f, 0.f};
        cur = nxt; cA = nA; cB = nB; ++ui;
        if constexpr (ALIGN_EPI) { if (wr == 1) PG8_BAR; }
    }
    PG8_WAIT_V(0);
    if constexpr (!ALIGN_EPI) { if (wr == 0) PG8_BAR; }
    PG8_BAR;
    if constexpr (Epi::AFTER_DRAIN) { E.fused(acc, cur, wr, wc, fr, fq, lds, wid, lane); S.done(cur); }
#undef PG8_SA
#undef PG8_SB
#undef PG8_STAGE
#undef PG8_LDA
#undef PG8_LDB
#undef PG8_MMA
#undef PG8_WAIT_V
#undef PG8_WAIT_L
#undef PG8_BAR
#undef PG8_SCHED
}
}

#define LAS __attribute__((address_space(3)))
typedef unsigned short bf16;
typedef float f32x4 __attribute__((ext_vector_type(4)));
typedef float f32x2 __attribute__((ext_vector_type(2)));
typedef short bf16x8 __attribute__((ext_vector_type(8)));
typedef short bf16x4 __attribute__((ext_vector_type(4)));
typedef unsigned u32x4 __attribute__((ext_vector_type(4)));
typedef unsigned u32x2 __attribute__((ext_vector_type(2)));

constexpr int NWAVES = 8, NTHREADS = 512;
constexpr int M = 16384, DM = 2048, FF = 5504, SEQ = 4096, NBATCH = 4, NH = 16, HD = 128;
constexpr float LN_EPS = 1e-5f;
constexpr int LDS_BYTES = 147456;
constexpr size_t SZ_WGU = (size_t)2 * FF * DM * 2, SZ_WD = (size_t)DM * FF * 2;
constexpr size_t WS_WGU = 0;
constexpr size_t WS_WD = WS_WGU + 4 * SZ_WGU;
constexpr size_t WS_WGLU = WS_WD + 4 * SZ_WD;
constexpr size_t WS_WQKV = WS_WGLU + (size_t)2 * DM * DM * 2;
constexpr size_t WS_WOUT = WS_WQKV + (size_t)3 * DM * DM * 2;
constexpr size_t WS_XB = WS_WOUT + (size_t)DM * DM * 2;
constexpr size_t WS_H = WS_XB + (size_t)M * DM * 2;
constexpr size_t WS_E = WS_H + (size_t)M * FF * 2;
constexpr size_t WS_END = WS_E + (size_t)M * DM * 4;
static_assert((size_t)M * DM * 4 <= (size_t)M * FF * 2, "Yf / Q|K fit in the h region");

__device__ __forceinline__ float wave_sum(float v) {
#pragma unroll
    for (int o = 1; o < 64; o <<= 1) v += __shfl_xor(v, o);
    return v;
}
__device__ __forceinline__ unsigned pk2(float lo, float hi) { return pg8::cvt_pk_bf16(lo, hi); }

__device__ __forceinline__ void conv_item(const float* W, int K, int N, bf16* WT, int mode, LAS float* scr, int item, int lane) {
    const int nblk = N / 32, kb = item / nblk, nb = item % nblk, k0 = 64 * kb, n0 = 32 * nb;
#pragma unroll
    for (int i = 0; i < 8; ++i) { const int kk = 8 * i + (lane >> 3), c4 = (lane & 7) * 4;
        const f32x4 v = *(const f32x4*)(W + (size_t)(k0 + kk) * N + n0 + c4);
        scr[kk * 33 + c4 + 0] = v[0]; scr[kk * 33 + c4 + 1] = v[1]; scr[kk * 33 + c4 + 2] = v[2]; scr[kk * 33 + c4 + 3] = v[3]; }
    asm volatile("s_waitcnt lgkmcnt(0)" ::: "memory");
    const int drow0 = (mode == 0) ? n0 : (256 * (n0 / 128) + (n0 % 128) + (mode == 2 ? 128 : 0));
    const int c = lane & 7;
#pragma unroll
    for (int j = 0; j < 4; ++j) { const int n = (lane >> 3) + 8 * j; const LAS float* s = scr + (8 * c) * 33 + n;
        u32x4 o; o.x = pk2(s[0 * 33], s[1 * 33]); o.y = pk2(s[2 * 33], s[3 * 33]); o.z = pk2(s[4 * 33], s[5 * 33]); o.w = pk2(s[6 * 33], s[7 * 33]);
        *(u32x4*)(WT + (size_t)(drow0 + n) * K + k0 + 8 * c) = o; }
    asm volatile("s_waitcnt lgkmcnt(0)" ::: "memory");
}
__device__ __forceinline__ void conv_matrix(const float* W, int K, int N, bf16* WT, int mode, LAS float* scr, int gw, int ngw, int lane) {
    const int nitems = (K / 64) * (N / 32);
    for (int it = gw; it < nitems; it += ngw) conv_item(W, K, N, WT, mode, scr, it, lane);
}

__device__ __forceinline__ void ln_phase(float* X, const float* g, const float* b, bf16* xb, int gw, int ngw, int lane) {
    for (int row = gw; row < M; row += ngw) {
        f32x4* xr = (f32x4*)(X + (size_t)row * DM) + lane;
        f32x4 v[8]; float s = 0.f;
#pragma unroll
        for (int j = 0; j < 8; ++j) { v[j] = xr[64 * j]; s += (v[j][0] + v[j][1]) + (v[j][2] + v[j][3]); }
        const float mean = wave_sum(s) * (1.f / DM); float s2 = 0.f;
#pragma unroll
        for (int j = 0; j < 8; ++j) { v[j] = v[j] - mean; s2 += (v[j][0] * v[j][0] + v[j][1] * v[j][1]) + (v[j][2] * v[j][2] + v[j][3] * v[j][3]); }
        const float rstd = 1.f / sqrtf(wave_sum(s2) * (1.f / DM) + LN_EPS);
        u32x2* o8 = (u32x2*)(xb + (size_t)row * DM) + lane;
#pragma unroll
        for (int j = 0; j < 8; ++j) { const f32x4 gv = ((const f32x4*)g)[lane + 64 * j], bv = ((const f32x4*)b)[lane + 64 * j];
            const f32x4 y = v[j] * rstd * gv + bv; xr[64 * j] = y;
            u32x2 w; w.x = pk2(y[0], y[1]); w.y = pk2(y[2], y[3]); o8[64 * j] = w; }
    }
}

__device__ __forceinline__ void s5_phase(const bf16* xb, const float* lam_re, const float* lam_im, const float* log_dt, const float* b_re, const float* b_im,
                                         const float* c_re, const float* c_im, float* Yf, float* Yb, LAS unsigned char* lds, int wave, int lane) {
    if (wave >= 4) return;
    LAS float* BU = (LAS float*)(lds + wave * 25600);
    LAS unsigned* SS = (LAS unsigned*)(lds + wave * 25600 + 16896);
    const int n = lane & 15, g4 = lane >> 4;
    for (int task = blockIdx.x * 4 + wave; task < 1024; task += gridDim.x * 4) {
        const int dir = task & 1, g = (task >> 1) & 127, b = task >> 8, dg = dir * 128 + g;
        const float dt = expf(log_dt[dg]);
        float lbr, lbi;
        { const float lr = fminf(lam_re[dg * 64 + lane], -1e-4f), li = lam_im[dg * 64 + lane]; const float mag = expf(lr * dt); lbr = mag * cosf(li * dt); lbi = mag * sinf(li * dt); }
        bf16x4 Bf[8];
#pragma unroll
        for (int nt = 0; nt < 8; ++nt) {
            const int p = 8 * nt + (n >> 1), part = n & 1;
            const float lr = fminf(lam_re[dg * 64 + p], -1e-4f), li = lam_im[dg * 64 + p]; const float mag = expf(lr * dt);
            const float pr = mag * cosf(li * dt), pi = mag * sinf(li * dt), den = lr * lr + li * li, nr = pr - 1.0f, ni = pi;
            const float fre = (nr * lr + ni * li) / den, fim = (ni * lr - nr * li) / den;
            const f32x4 br = *(const f32x4*)(b_re + ((size_t)dg * 64 + p) * 16 + 4 * g4), bi = *(const f32x4*)(b_im + ((size_t)dg * 64 + p) * 16 + 4 * g4);
            const f32x4 v = part == 0 ? (br * fre - bi * fim) : (bi * fre + br * fim);
            const unsigned w0 = pk2(v[0], v[1]), w1 = pk2(v[2], v[3]);
            Bf[nt] = __builtin_bit_cast(bf16x4, (u32x2){w0, w1});
        }
        bf16x8 Cf[4];
#pragma unroll
        for (int kc = 0; kc < 4; ++kc) {
            float cv[8];
#pragma unroll
            for (int e = 0; e < 8; ++e) { const int p = 16 * kc + 4 * g4 + (e >> 1); const size_t ci = ((size_t)dg * 16 + n) * 64 + p; cv[e] = (e & 1) ? -c_im[ci] : c_re[ci]; }
            Cf[kc] = __builtin_bit_cast(bf16x8, (u32x4){pk2(cv[0], cv[1]), pk2(cv[2], cv[3]), pk2(cv[4], cv[5]), pk2(cv[6], cv[7])});
        }
        float s_re = 0.f, s_im = 0.f;
        const bf16* xrow = xb + (size_t)b * SEQ * DM + g * 16 + 4 * g4;
        float* Y = (dir ? Yb : Yf) + (size_t)b * SEQ * DM + g * 16 + n;
        int t0 = dir ? SEQ - 32 : 0;
        u32x2 a0 = *(const u32x2*)(xrow + (size_t)(t0 + n) * DM), a1 = *(const u32x2*)(xrow + (size_t)(t0 + 16 + n) * DM);
        for (int ci = 0; ci < SEQ / 32; ++ci) {
            t0 = dir ? SEQ - 32 * (ci + 1) : 32 * ci;
            const bf16x4 A0 = __builtin_bit_cast(bf16x4, a0), A1 = __builtin_bit_cast(bf16x4, a1);
            if (ci + 1 < SEQ / 32) { const int tn = dir ? t0 - 32 : t0 + 32; a0 = *(const u32x2*)(xrow + (size_t)(tn + n) * DM); a1 = *(const u32x2*)(xrow + (size_t)(tn + 16 + n) * DM); }
#pragma unroll
            for (int nt = 0; nt < 8; ++nt) {
                const f32x4 z = {0.f, 0.f, 0.f, 0.f};
                const f32x4 d0 = __builtin_amdgcn_mfma_f32_16x16x16bf16_1k(A0, Bf[nt], z, 0, 0, 0);
                const f32x4 d1 = __builtin_amdgcn_mfma_f32_16x16x16bf16_1k(A1, Bf[nt], z, 0, 0, 0);
#pragma unroll
                for (int j = 0; j < 4; ++j) { BU[(4 * g4 + j) * 132 + 16 * nt + n] = d0[j]; BU[(16 + 4 * g4 + j) * 132 + 16 * nt + n] = d1[j]; }
            }
#pragma unroll
            for (int step = 0; step < 32; ++step) {
                const int t = dir ? 31 - step : step;
                const f32x2 bu = *(const LAS f32x2*)(BU + t * 132 + 2 * lane);
                const float nr = __builtin_fmaf(lbr, s_re, __builtin_fmaf(-lbi, s_im, bu[0]));
                const float ni = __builtin_fmaf(lbr, s_im, __builtin_fmaf(lbi, s_re, bu[1]));
                s_re = nr; s_im = ni;
                SS[t * 68 + lane] = pk2(nr, ni);
            }
#pragma unroll
            for (int tt = 0; tt < 2; ++tt) {
                f32x4 acc = {0.f, 0.f, 0.f, 0.f};
#pragma unroll
                for (int kc = 0; kc < 4; ++kc) { const bf16x8 A = *(const LAS bf16x8*)(SS + (16 * tt + n) * 68 + 16 * kc + 4 * g4); acc = __builtin_amdgcn_mfma_f32_16x16x32_bf16(A, Cf[kc], acc, 0, 0, 0); }
#pragma unroll
                for (int j = 0; j < 4; ++j) Y[(size_t)(t0 + 16 * tt + 4 * g4 + j) * DM] = acc[j];
            }
        }
    }
}

__device__ __forceinline__ void natten_phase(const bf16* Q, const bf16* K, const bf16* VT, bf16* O, const float* rpb, LAS unsigned char* lds, int tid, int wave, int lane) {
    LAS float* RP = (LAS float*)lds;
    for (int i = tid; i < 16 * 465; i += NTHREADS) RP[i] = rpb[i];
    __syncthreads();
    const int n = lane & 15, g4 = lane >> 4;
    const int ntask = 16384, per = (ntask + gridDim.x - 1) / gridDim.x;
    for (int i = wave; i < per; i += NWAVES) {
        const int task = blockIdx.x * per + i; if (task >= ntask) break;
        const int cg_ = task & 3, r = (task >> 2) & 63, h = (task >> 8) & 15, b = task >> 12;
        const int rs = min(max(r - 4, 0), 56), cbase = min(max(16 * cg_ - 8, 0), 32);
        const size_t tokb = (size_t)b * SEQ;
        const bf16* qp = Q + (tokb + r * 64 + cg_ * 16 + n) * DM + h * HD + 8 * g4;
        bf16x8 qf[4];
#pragma unroll
        for (int kc = 0; kc < 4; ++kc) qf[kc] = *(const bf16x8*)(qp + 32 * kc);
        f32x4 s[16];
#pragma unroll
        for (int j = 0; j < 16; ++j) {
            const bf16* kp = K + (tokb + (rs + (j >> 1)) * 64 + cbase + 16 * (j & 1) + n) * DM + h * HD + 8 * g4;
            f32x4 acc = {0.f, 0.f, 0.f, 0.f};
#pragma unroll
            for (int kc = 0; kc < 4; ++kc) { const bf16x8 kf = *(const bf16x8*)(kp + 32 * kc); acc = __builtin_amdgcn_mfma_f32_16x16x32_bf16(kf, qf[kc], acc, 0, 0, 0); }
            s[j] = acc;
        }
        const int c = 16 * cg_ + n, cs = min(max(c - 8, 0), 48);
        const LAS float* rph = RP + h * 465;
        float mx = -1e30f;
#pragma unroll
        for (int j = 0; j < 16; ++j) {
            const int rowoff = rs + (j >> 1) - r + 7;
#pragma unroll
            for (int e = 0; e < 4; ++e) {
                const int kcol = cbase + 16 * (j & 1) + 4 * g4 + e; const bool valid = (kcol >= cs) && (kcol < cs + 16);
                const int coff = min(max(kcol - c + 15, 0), 30);
                const float v = valid ? s[j][e] + rph[rowoff * 31 + coff] : -1e30f;
                s[j][e] = v; mx = fmaxf(mx, v);
            }
        }
        mx = fmaxf(mx, __shfl_xor(mx, 16)); mx = fmaxf(mx, __shfl_xor(mx, 32));
        float sum = 0.f;
#pragma unroll
        for (int j = 0; j < 16; ++j)
#pragma unroll
            for (int e = 0; e < 4; ++e) { const float p = __expf(s[j][e] - mx); s[j][e] = p; sum += p; }
        sum += __shfl_xor(sum, 16); sum += __shfl_xor(sum, 32);
        const float inv = 1.0f / sum;
        f32x4 o[8];
#pragma unroll
        for (int mt = 0; mt < 8; ++mt) o[mt] = (f32x4){0.f, 0.f, 0.f, 0.f};
#pragma unroll
        for (int jj = 0; jj < 8; ++jj) {
            const bf16x8 pf = __builtin_bit_cast(bf16x8, (u32x4){pk2(s[2 * jj][0], s[2 * jj][1]), pk2(s[2 * jj][2], s[2 * jj][3]), pk2(s[2 * jj + 1][0], s[2 * jj + 1][1]), pk2(s[2 * jj + 1][2], s[2 * jj + 1][3])});
            const bf16* vp = VT + (size_t)(h * HD + n) * M + tokb + (rs + jj) * 64 + cbase + 4 * g4;
#pragma unroll
            for (int mt = 0; mt < 8; ++mt) {
                const u32x2 lo = *(const u32x2*)(vp + (size_t)(16 * mt) * M), hi = *(const u32x2*)(vp + (size_t)(16 * mt) * M + 16);
                const bf16x8 vf = __builtin_bit_cast(bf16x8, (u32x4){lo.x, lo.y, hi.x, hi.y});
                o[mt] = __builtin_amdgcn_mfma_f32_16x16x32_bf16(vf, pf, o[mt], 0, 0, 0);
            }
        }
        bf16* op = O + (tokb + r * 64 + cg_ * 16 + n) * DM + h * HD + 4 * g4;
#pragma unroll
        for (int mt = 0; mt < 8; ++mt) { u32x2 w; w.x = pk2(o[mt][0] * inv, o[mt][1] * inv); w.y = pk2(o[mt][2] * inv, o[mt][3] * inv); *(u32x2*)(op + 16 * mt) = w; }
    }
}

struct Args { const float* in[19]; float* out; unsigned char* ws; int ph_lo, ph_hi; };
constexpr int N_PHASES = 21;
#ifndef DIS_S5
#define DIS_S5 0
#endif
#ifndef DIS_ATT
#define DIS_ATT 0
#endif
#ifndef DIS_GEMM
#define DIS_GEMM 0
#endif
#ifndef GEMM_MASK
#define GEMM_MASK 0xff
#endif
#ifndef MK_PER_PHASE
#define MK_PER_PHASE 0
#endif

__global__ void __launch_bounds__(NTHREADS, 2) mega_fwd(Args args) {
    extern __shared__ __attribute__((aligned(16))) unsigned char lds_raw[];
    LAS unsigned char* lds = (LAS unsigned char*)lds_raw;
    const int tid = threadIdx.x, lane = tid & 63, wave = __builtin_amdgcn_readfirstlane(tid >> 6);
    const int G = gridDim.x, gw = blockIdx.x * NWAVES + wave, ngw = G * NWAVES;
    unsigned char* ws = args.ws;
    const float* x_in = args.in[0];
    float* out = args.out;
    bf16* Wgu = (bf16*)(ws + WS_WGU); bf16* Wd = (bf16*)(ws + WS_WD); bf16* Wglu = (bf16*)(ws + WS_WGLU); bf16* Wqkv = (bf16*)(ws + WS_WQKV); bf16* Wout = (bf16*)(ws + WS_WOUT);
    bf16* XB = (bf16*)(ws + WS_XB); bf16* HB = (bf16*)(ws + WS_H);
    float* Yf = (float*)(ws + WS_H); float* Yb = (float*)(ws + WS_E);
    bf16* Qb = (bf16*)(ws + WS_H); bf16* Kb = Qb + (size_t)M * DM; bf16* VT = (bf16*)(ws + WS_E); bf16* Ob = VT + (size_t)M * DM;
    const int lo = args.ph_lo, hi = args.ph_hi;
    int pid = 0;
#define RUN() (lo <= pid && pid < hi)
#if MK_PER_PHASE
#define END_PHASE() do { ++pid; } while (0)
#else
#define END_PHASE() do { if (lo <= pid && pid + 1 < hi) cg::this_grid().sync(); ++pid; } while (0)
#endif

    if (RUN()) {
        LAS float* scr = (LAS float*)(lds + wave * 16384);
        for (int f = 0; f < 4; ++f) {
            conv_matrix(args.in[1] + (size_t)f * DM * FF, DM, FF, Wgu + (size_t)f * 2 * FF * DM, 1, scr, gw, ngw, lane);
            conv_matrix(args.in[2] + (size_t)f * DM * FF, DM, FF, Wgu + (size_t)f * 2 * FF * DM, 2, scr, gw, ngw, lane);
            conv_matrix(args.in[3] + (size_t)f * FF * DM, FF, DM, Wd + (size_t)f * DM * FF, 0, scr, gw, ngw, lane);
        }
        conv_matrix(args.in[14], DM, DM, Wglu, 1, scr, gw, ngw, lane);
        conv_matrix(args.in[15], DM, DM, Wglu, 2, scr, gw, ngw, lane);
        conv_matrix(args.in[16], DM, 3 * DM, Wqkv, 0, scr, gw, ngw, lane);
        conv_matrix(args.in[18], DM, DM, Wout, 0, scr, gw, ngw, lane);
        for (size_t i = (size_t)blockIdx.x * NTHREADS + tid; i < (size_t)M * DM / 8; i += (size_t)G * NTHREADS) {
            const f32x4 v0 = ((const f32x4*)x_in)[2 * i], v1 = ((const f32x4*)x_in)[2 * i + 1];
            u32x4 w; w.x = pk2(v0[0], v0[1]); w.y = pk2(v0[2], v0[3]); w.z = pk2(v1[0], v1[1]); w.w = pk2(v1[2], v1[3]);
            ((u32x4*)XB)[i] = w;
        }
    }
    END_PHASE();

    {
        if (RUN()) {
            pg8::Gemm g{XB, Wgu + (size_t)0 * 2 * FF * DM, M, 2 * FF, DM}; pg8::StaticOrder S; S.init(M, 2 * FF, G, (int)blockIdx.x);
            pg8::EpiSwiGLU E{HB, FF};
            if (!DIS_GEMM && ((GEMM_MASK >> 0) & 1)) pg8::gemm_phase<pg8::EpiSwiGLU, pg8::StaticOrder, true, true>(lds, g, S, E);
        }
        END_PHASE();
        if (RUN()) {
            pg8::Gemm g{HB, Wd + (size_t)0 * DM * FF, M, DM, FF}; pg8::StaticOrder S; S.init(M, DM, G, (int)blockIdx.x);
            pg8::EpiResid E{x_in, out, 0.5f};
            if (!DIS_GEMM && ((GEMM_MASK >> 1) & 1)) pg8::gemm_phase<pg8::EpiResid, pg8::StaticOrder, true, true>(lds, g, S, E);
        }
        END_PHASE();
        if (RUN()) { const int li = 0; ln_phase(out, args.in[4] + li * DM, args.in[5] + li * DM, XB, gw, ngw, lane); }
        END_PHASE();

    }
    {
            if (RUN() && !DIS_S5) s5_phase(XB, args.in[6], args.in[7], args.in[8], args.in[9], args.in[10], args.in[11], args.in[12], Yf, Yb, lds, wave, lane);
            END_PHASE();
            if (RUN()) {
                const float* dsk = args.in[13];
                for (size_t i = (size_t)blockIdx.x * NTHREADS + tid; i < (size_t)M * DM / 4; i += (size_t)G * NTHREADS) {
                    const f32x4 a = ((const f32x4*)Yf)[i], bb = ((const f32x4*)Yb)[i], xv = ((const f32x4*)out)[i], dv = ((const f32x4*)dsk)[i & (DM / 4 - 1)];
                    const f32x4 y = a + bb + dv * xv; float gq[4];
#pragma unroll
                    for (int e = 0; e < 4; ++e) { const float t = y[e], z = 1.5957691216057308f * (t + 0.044715f * t * t * t); gq[e] = t * pg8::fast_sigmoid(z); }
                    u32x2 w; w.x = pk2(gq[0], gq[1]); w.y = pk2(gq[2], gq[3]); ((u32x2*)XB)[i] = w;
                }
            }
            END_PHASE();
            if (RUN()) {
                pg8::Gemm g{XB, Wglu, M, 2 * DM, DM}; pg8::StaticOrder S; S.init(M, 2 * DM, G, (int)blockIdx.x);
                pg8::EpiGLU E{out, out};
                if (!DIS_GEMM && ((GEMM_MASK >> 2) & 1)) pg8::gemm_phase<pg8::EpiGLU, pg8::StaticOrder, true, true>(lds, g, S, E);
            }
            END_PHASE();
            if (RUN()) ln_phase(out, args.in[4] + 1 * DM, args.in[5] + 1 * DM, XB, gw, ngw, lane);
            END_PHASE();
            }
    {
        if (RUN()) {
            pg8::Gemm g{XB, Wgu + (size_t)1 * 2 * FF * DM, M, 2 * FF, DM}; pg8::StaticOrder S; S.init(M, 2 * FF, G, (int)blockIdx.x);
            pg8::EpiSwiGLU E{HB, FF};
            if (!DIS_GEMM && ((GEMM_MASK >> 0) & 1)) pg8::gemm_phase<pg8::EpiSwiGLU, pg8::StaticOrder, true, true>(lds, g, S, E);
        }
        END_PHASE();
        if (RUN()) {
            pg8::Gemm g{HB, Wd + (size_t)1 * DM * FF, M, DM, FF}; pg8::StaticOrder S; S.init(M, DM, G, (int)blockIdx.x);
            pg8::EpiResid E{out, out, 0.5f};
            if (!DIS_GEMM && ((GEMM_MASK >> 1) & 1)) pg8::gemm_phase<pg8::EpiResid, pg8::StaticOrder, true, true>(lds, g, S, E);
        }
        END_PHASE();
        if (RUN()) { const int li = 2; ln_phase(out, args.in[4] + li * DM, args.in[5] + li * DM, XB, gw, ngw, lane); }
        END_PHASE();

    }
    {
        if (RUN()) {
            pg8::Gemm g{XB, Wgu + (size_t)2 * 2 * FF * DM, M, 2 * FF, DM}; pg8::StaticOrder S; S.init(M, 2 * FF, G, (int)blockIdx.x);
            pg8::EpiSwiGLU E{HB, FF};
            if (!DIS_GEMM && ((GEMM_MASK >> 0) & 1)) pg8::gemm_phase<pg8::EpiSwiGLU, pg8::StaticOrder, true, true>(lds, g, S, E);
        }
        END_PHASE();
        if (RUN()) {
            pg8::Gemm g{HB, Wd + (size_t)2 * DM * FF, M, DM, FF}; pg8::StaticOrder S; S.init(M, DM, G, (int)blockIdx.x);
            pg8::EpiResid E{out, out, 0.5f};
            if (!DIS_GEMM && ((GEMM_MASK >> 1) & 1)) pg8::gemm_phase<pg8::EpiResid, pg8::StaticOrder, true, true>(lds, g, S, E);
        }
        END_PHASE();
        if (RUN()) { const int li = 3; ln_phase(out, args.in[4] + li * DM, args.in[5] + li * DM, XB, gw, ngw, lane); }
        END_PHASE();

    }
    {
            if (RUN()) {
                { pg8::Gemm g{XB, Wqkv, M, 2 * DM, DM}; pg8::StaticOrder S; S.init(M, 2 * DM, G, (int)blockIdx.x);
                  pg8::EpiQK E{Qb, Kb, 0.08838834764831845f};
                  if (!DIS_GEMM && ((GEMM_MASK >> 3) & 1)) pg8::gemm_phase<pg8::EpiQK, pg8::StaticOrder, true, true>(lds, g, S, E); }
                { pg8::Gemm g{XB, Wqkv + (size_t)2 * DM * DM, M, DM, DM}; pg8::StaticOrder S; S.init(M, DM, G, (int)blockIdx.x);
                  pg8::EpiVT E{VT};
                  if (!DIS_GEMM && ((GEMM_MASK >> 4) & 1)) pg8::gemm_phase<pg8::EpiVT, pg8::StaticOrder, true, true>(lds, g, S, E); }
            }
            END_PHASE();
            if (RUN() && !DIS_ATT) natten_phase(Qb, Kb, VT, Ob, args.in[17], lds, tid, wave, lane);
            END_PHASE();
            if (RUN()) {
                pg8::Gemm g{Ob, Wout, M, DM, DM}; pg8::StaticOrder S; S.init(M, DM, G, (int)blockIdx.x);
                pg8::EpiResid E{out, out, 1.0f};
                if (!DIS_GEMM && ((GEMM_MASK >> 5) & 1)) pg8::gemm_phase<pg8::EpiResid, pg8::StaticOrder, true, true>(lds, g, S, E);
            }
            END_PHASE();
            if (RUN()) ln_phase(out, args.in[4] + 4 * DM, args.in[5] + 4 * DM, XB, gw, ngw, lane);
            END_PHASE();
            }
    {
        if (RUN()) {
            pg8::Gemm g{XB, Wgu + (size_t)3 * 2 * FF * DM, M, 2 * FF, DM}; pg8::StaticOrder S; S.init(M, 2 * FF, G, (int)blockIdx.x);
            pg8::EpiSwiGLU E{HB, FF};
            if (!DIS_GEMM && ((GEMM_MASK >> 0) & 1)) pg8::gemm_phase<pg8::EpiSwiGLU, pg8::StaticOrder, true, true>(lds, g, S, E);
        }
        END_PHASE();
        if (RUN()) {
            pg8::Gemm g{HB, Wd + (size_t)3 * DM * FF, M, DM, FF}; pg8::StaticOrder S; S.init(M, DM, G, (int)blockIdx.x);
            pg8::EpiResid E{out, out, 0.5f};
            if (!DIS_GEMM && ((GEMM_MASK >> 1) & 1)) pg8::gemm_phase<pg8::EpiResid, pg8::StaticOrder, true, true>(lds, g, S, E);
        }
        END_PHASE();
        if (RUN()) { const int li = 5; ln_phase(out, args.in[4] + li * DM, args.in[5] + li * DM, XB, gw, ngw, lane); }
        END_PHASE();

    }
#undef RUN
#undef END_PHASE
}

extern "C" void kernel_launch(void* const* d_in, const int* in_sizes, int n_in, void* d_out, int out_size, void* d_ws, size_t ws_size, hipStream_t stream) {
    static int grid = 0;
    if (grid == 0) {
        if (n_in != 19 || in_sizes[0] != M * DM || out_size != M * DM || ws_size < WS_END) { fprintf(stderr, "kernel_launch: unexpected shapes / workspace (n_in %d, ws %zu < %zu)\n", n_in, ws_size, (size_t)WS_END); grid = -1; return; }
        int dev = 0, cus = 0, per_cu = 0;
        if (hipGetDevice(&dev) != hipSuccess || hipDeviceGetAttribute(&cus, hipDeviceAttributeMultiprocessorCount, dev) != hipSuccess) { grid = -1; return; }
        if (hipFuncSetAttribute((const void*)mega_fwd, hipFuncAttributeMaxDynamicSharedMemorySize, LDS_BYTES) != hipSuccess) { fprintf(stderr, "kernel_launch: hipFuncSetAttribute failed\n"); grid = -1; return; }
        if (hipOccupancyMaxActiveBlocksPerMultiprocessor(&per_cu, (const void*)mega_fwd, NTHREADS, LDS_BYTES) != hipSuccess || per_cu < 1) { fprintf(stderr, "kernel_launch: occupancy query says %d\n", per_cu); per_cu = 1; }
        (void)hipGetLastError();
        grid = cus * per_cu;
    }
    if (grid < 0) return;
    Args a{};
    for (int i = 0; i < 19; ++i) a.in[i] = (const float*)d_in[i];
    a.out = (float*)d_out; a.ws = (unsigned char*)d_ws;
#if MK_PER_PHASE
    for (int p = 0; p < N_PHASES; ++p) { a.ph_lo = p; a.ph_hi = p + 1; hipLaunchKernelGGL(mega_fwd, dim3(grid), dim3(NTHREADS), LDS_BYTES, stream, a); }
#else
    a.ph_lo = 0; a.ph_hi = N_PHASES;
    void* kargs[] = {&a};
    hipError_t e = hipLaunchCooperativeKernel((const void*)mega_fwd, dim3(grid), dim3(NTHREADS), kargs, LDS_BYTES, stream);
    if (e != hipSuccess) fprintf(stderr, "kernel_launch: cooperative launch failed: %s (grid %d)\n", hipGetErrorString(e), grid);
#endif
}
```

```cpp
#include <hip/hip_runtime.h>
#include <hip/hip_cooperative_groups.h>
#include <cstdio>
#include <cstdint>
namespace cg = cooperative_groups;
namespace pg8 {
#define PG8_LAS __attribute__((address_space(3)))
typedef unsigned short bf16_t;
typedef short bf16x8 __attribute__((ext_vector_type(8)));
typedef float f32x4 __attribute__((ext_vector_type(4)));
typedef unsigned u32x4 __attribute__((ext_vector_type(4)));
constexpr int BM = 256, BK = 64, HALF = 128, HTB = HALF * BK * 2  , STAGE_BYTES = 8 * HTB, NXCD = 8, WGM = 8;

__host__ __device__ __forceinline__ int lds_byte(int r, int c) { const int st = (r >> 4) * 2 + (c >> 5), rr = r & 15, cc = c & 31, ob = rr * 64 + cc * 2; return st * 1024 + (ob ^ (((ob >> 9) & 1) << 5)); }
__host__ __device__ __forceinline__ void stage_rc(int b, int& R, int& C) { const int st = b / 1024, sb = b % 1024, swz = sb ^ (((sb >> 9) & 1) << 5); R = (st >> 1) * 16 + swz / 64; C = (st & 1) * 32 + (swz % 64) / 2; }
__host__ __device__ __forceinline__ int perm32(int rho) { const int n = rho >> 4, i = rho & 15; return 8 * (i >> 2) + 4 * n + (i & 3); }

struct Unit { int pm, pn; };
struct Gemm { const bf16_t* A; const bf16_t* Bt; int M, N, K; };

struct StaticOrder {
    int nM, nN, nwg, G, c;
    __host__ __device__ void init(int M, int N, int G_, int c_) { nM = M / BM; nN = N / BM; nwg = nM * nN; G = G_; c = c_; }
    __host__ __device__ bool next(int i, Unit& u) const {
        const long L = (long)i * G + c; if (L >= nwg) return false;
        int wgid = (int)L; { const int q = nwg / NXCD, r = nwg % NXCD, xcd = wgid % NXCD, off = wgid / NXCD; wgid = (xcd < r ? xcd * (q + 1) : r * (q + 1) + (xcd - r) * q) + off; }
        const int nig = WGM * nN, gid = wgid / nig, fm = gid * WGM, gsz = (nM - fm) < WGM ? (nM - fm) : WGM;
        u.pm = fm + ((wgid % nig) % gsz); u.pn = (wgid % nig) / gsz; return true;
    }
    __device__ __forceinline__ void a_ready(const Unit&) const {}
    __device__ __forceinline__ void done(const Unit&) const {}
};

__device__ __forceinline__ unsigned cvt_pk_bf16(float lo, float hi) { unsigned r; asm volatile("v_cvt_pk_bf16_f32 %0, %1, %2" : "=v"(r) : "v"(lo), "v"(hi)); return r; }
__device__ __forceinline__ float fast_sigmoid(float v) { return __builtin_amdgcn_rcpf(1.0f + __expf(-v)); }
constexpr float ALPHA_RES = 1.41421356237309515f;

struct EpiSwiGLU {
    static constexpr bool PERM = true, AFTER_DRAIN = false, SWAP = false;
    bf16_t* H; int ldh;
    __device__ __forceinline__ void operator()(const f32x4 (&acc)[2][2][4][2], const Unit& u, int wr, int wc, int fr, int fq) const {
        const int row0 = u.pm * BM + wr * 64 + fr, col0 = u.pn * HALF + wc * 32 + 8 * fq;
#pragma unroll
        for (int ai = 0; ai < 2; ++ai)
#pragma unroll
            for (int m = 0; m < 4; ++m) {
                bf16_t* rowp = H + (size_t)(row0 + ai * HALF + m * 16) * ldh + col0;
                float o[8];
#pragma unroll
                for (int n = 0; n < 2; ++n)
#pragma unroll
                    for (int e = 0; e < 4; ++e) { const float g = acc[ai][0][m][n][e], up = acc[ai][1][m][n][e]; o[4 * n + e] = g * fast_sigmoid(g) * up; }
                u32x4 w; w.x = cvt_pk_bf16(o[0], o[1]); w.y = cvt_pk_bf16(o[2], o[3]); w.z = cvt_pk_bf16(o[4], o[5]); w.w = cvt_pk_bf16(o[6], o[7]);
                *(u32x4*)rowp = w;
            }
    }
};
struct EpiResid {
    static constexpr bool PERM = true, AFTER_DRAIN = false, SWAP = false;
    const float* xin; float* Y; float scale;
    __device__ __forceinline__ void operator()(const f32x4 (&acc)[2][2][4][2], const Unit& u, int wr, int wc, int fr, int fq) const {
        const int row0 = u.pm * BM + wr * 64 + fr, col0 = u.pn * BM + wc * 32 + 8 * fq;
#pragma unroll
        for (int ai = 0; ai < 2; ++ai) {
            f32x4 xv[4][2][2];
#pragma unroll
            for (int m = 0; m < 4; ++m) { const size_t off = (size_t)(row0 + ai * HALF + m * 16) * 2048 + col0;
#pragma unroll
                for (int bj = 0; bj < 2; ++bj)
#pragma unroll
                    for (int n = 0; n < 2; ++n) xv[m][bj][n] = *(const f32x4*)(xin + off + bj * HALF + 4 * n); }
#pragma unroll
            for (int m = 0; m < 4; ++m) { const size_t off = (size_t)(row0 + ai * HALF + m * 16) * 2048 + col0;
#pragma unroll
                for (int bj = 0; bj < 2; ++bj)
#pragma unroll
                    for (int n = 0; n < 2; ++n) *(f32x4*)(Y + off + bj * HALF + 4 * n) = xv[m][bj][n] * ALPHA_RES + acc[ai][bj][m][n] * scale; }
            asm volatile("" ::: "memory");
        }
    }
};
struct EpiGLU {
    static constexpr bool PERM = true, AFTER_DRAIN = false, SWAP = false;
    const float* xin; float* Y;
    __device__ __forceinline__ void operator()(const f32x4 (&acc)[2][2][4][2], const Unit& u, int wr, int wc, int fr, int fq) const {
        const int row0 = u.pm * BM + wr * 64 + fr, col0 = u.pn * HALF + wc * 32 + 8 * fq;
#pragma unroll
        for (int ai = 0; ai < 2; ++ai) {
            f32x4 xv[4][2];
#pragma unroll
            for (int m = 0; m < 4; ++m)
#pragma unroll
                for (int n = 0; n < 2; ++n) xv[m][n] = *(const f32x4*)(xin + (size_t)(row0 + ai * HALF + m * 16) * 2048 + col0 + 4 * n);
#pragma unroll
            for (int m = 0; m < 4; ++m)
#pragma unroll
                for (int n = 0; n < 2; ++n) { f32x4 o;
#pragma unroll
                    for (int e = 0; e < 4; ++e) o[e] = xv[m][n][e] * ALPHA_RES + acc[ai][0][m][n][e] * fast_sigmoid(acc[ai][1][m][n][e]);
                    *(f32x4*)(Y + (size_t)(row0 + ai * HALF + m * 16) * 2048 + col0 + 4 * n) = o; }
            asm volatile("" ::: "memory");
        }
    }
};
struct EpiQK {
    static constexpr bool PERM = true, AFTER_DRAIN = false, SWAP = false;
    bf16_t* Q; bf16_t* K; float qscale;
    __device__ __forceinline__ void operator()(const f32x4 (&acc)[2][2][4][2], const Unit& u, int wr, int wc, int fr, int fq) const {
        const int row0 = u.pm * BM + wr * 64 + fr; int colt = u.pn * BM; bf16_t* base = Q; float sc = qscale;
        if (colt >= 2048) { colt -= 2048; base = K; sc = 1.0f; }
        const int col0 = colt + wc * 32 + 8 * fq;
#pragma unroll
        for (int ai = 0; ai < 2; ++ai)
#pragma unroll
            for (int m = 0; m < 4; ++m) {
                bf16_t* rowp = base + (size_t)(row0 + ai * HALF + m * 16) * 2048 + col0;
#pragma unroll
                for (int bj = 0; bj < 2; ++bj) { const f32x4 v0 = acc[ai][bj][m][0] * sc, v1 = acc[ai][bj][m][1] * sc;
                    u32x4 w; w.x = cvt_pk_bf16(v0[0], v0[1]); w.y = cvt_pk_bf16(v0[2], v0[3]); w.z = cvt_pk_bf16(v1[0], v1[1]); w.w = cvt_pk_bf16(v1[2], v1[3]);
                    *(u32x4*)(rowp + bj * HALF) = w; }
            }
    }
};
struct EpiVT {
    static constexpr bool PERM = false, AFTER_DRAIN = false, SWAP = true;
    bf16_t* VT;
    __device__ __forceinline__ void operator()(const f32x4 (&acc)[2][2][4][2], const Unit& u, int wr, int wc, int fr, int fq) const {
        typedef unsigned u32x2 __attribute__((ext_vector_type(2)));
        const int tok0 = u.pm * BM + wr * 64 + 4 * fq, col0 = u.pn * BM + wc * 32 + fr;
#pragma unroll
        for (int bj = 0; bj < 2; ++bj)
#pragma unroll
            for (int n = 0; n < 2; ++n) {
                bf16_t* cp = VT + (size_t)(col0 + bj * HALF + n * 16) * 16384 + tok0;
#pragma unroll
                for (int ai = 0; ai < 2; ++ai)
#pragma unroll
                    for (int m = 0; m < 4; ++m) { const f32x4 v = acc[ai][bj][m][n]; u32x2 w; w.x = cvt_pk_bf16(v[0], v[1]); w.y = cvt_pk_bf16(v[2], v[3]);
                        *(u32x2*)(cp + ai * HALF + m * 16) = w; }
            }
    }
};


template <class Epi, class Sched, bool ALIGN_EPI = false, bool SP2 = false>
__device__ __forceinline__ void gemm_phase(PG8_LAS unsigned char* lds, const Gemm g, const Sched& S, const Epi& E) {
    int tid_opaque = threadIdx.x; asm volatile("" : "+v"(tid_opaque));
    const int tid = tid_opaque, wid = __builtin_amdgcn_readfirstlane(tid >> 6), lane = tid & 63, wr = wid >> 2, wc = wid & 3, fr = lane & 15, fq = lane >> 4;
    const int K = g.K, nt = K / BK;
    unsigned voffA[2], voffB[2];
#pragma unroll
    for (int i = 0; i < 2; ++i) { int R, C; stage_rc(tid * 16 + i * 8192, R, C); const int Rb = Epi::PERM ? ((R & ~31) + perm32(R & 31)) : R;
        voffA[i] = (unsigned)(R * K + C) * 2u; voffB[i] = (unsigned)(Rb * K + C) * 2u; }
    const size_t kstep = (size_t)(BK * 2);
    const size_t hstep = (size_t)HALF * K * 2;
    const size_t tstep = 2 * hstep;
    const unsigned ldsw = (unsigned)wid * 1024u;
    const int aoff = lds_byte(wr * 64 + fr, fq * 8), boff = lds_byte(wc * 32 + fr, fq * 8);
#define PG8_SA(b, h) (((b) * 2 + (h)) * HTB)
#define PG8_SB(b, h) ((4 + (b) * 2 + (h)) * HTB)
#define PG8_STAGE(bufoff, gbase, voff) do { _Pragma("unroll") for (int _i = 0; _i < 2; ++_i) \
        __builtin_amdgcn_global_load_lds((const unsigned*)((const char*)(gbase) + (voff)[_i]), (PG8_LAS unsigned*)(lds + (bufoff) + ldsw + _i * 8192), 16, 0, 0); } while (0)
#define PG8_LDA(dst, b, h) do { _Pragma("unroll") for (int m = 0; m < 4; ++m) _Pragma("unroll") for (int k = 0; k < 2; ++k) dst[m][k] = *(const PG8_LAS bf16x8*)(lds + PG8_SA(b, h) + aoff + m * 2048 + k * 1024); } while (0)
#define PG8_LDB(dst, b, h) do { _Pragma("unroll") for (int n = 0; n < 2; ++n) _Pragma("unroll") for (int k = 0; k < 2; ++k) dst[n][k] = *(const PG8_LAS bf16x8*)(lds + PG8_SB(b, h) + boff + n * 2048 + k * 1024); } while (0)
#define PG8_MMA(ai, bj, At, Bt) do { __builtin_amdgcn_s_setprio(1); _Pragma("unroll") for (int m = 0; m < 4; ++m) _Pragma("unroll") for (int n = 0; n < 2; ++n) _Pragma("unroll") for (int k = 0; k < 2; ++k) \
        acc[ai][bj][m][n] = Epi::SWAP ? __builtin_amdgcn_mfma_f32_16x16x32_bf16(At[m][k], Bt[n][k], acc[ai][bj][m][n], 0, 0, 0) : __builtin_amdgcn_mfma_f32_16x16x32_bf16(Bt[n][k], At[m][k], acc[ai][bj][m][n], 0, 0, 0); __builtin_amdgcn_s_setprio(0); } while (0)
#define PG8_WAIT_V(n) asm volatile("s_waitcnt vmcnt(" #n ")" ::: "memory")
#define PG8_WAIT_L(n) asm volatile("s_waitcnt lgkmcnt(" #n ")" ::: "memory")
#define PG8_BAR __builtin_amdgcn_s_barrier()
#define PG8_SCHED __builtin_amdgcn_sched_barrier(0)
    Unit cur, nxt; int ui = 0;
    if (!S.next(0, cur)) return;
    f32x4 acc[2][2][4][2];
#pragma unroll
    for (int a = 0; a < 2; ++a)
#pragma unroll
        for (int b = 0; b < 2; ++b)
#pragma unroll
            for (int m = 0; m < 4; ++m)
#pragma unroll
                for (int n = 0; n < 2; ++n) acc[a][b][m][n] = (f32x4){0.f, 0.f, 0.f, 0.f};
    bf16x8 At[4][2], B0[2][2], B1[2][2];
    const char* cA = (const char*)g.A + (size_t)cur.pm * tstep; const char* cB = (const char*)g.Bt + (size_t)cur.pn * tstep;
    S.a_ready(cur);
    if constexpr (SP2) {
        PG8_STAGE(PG8_SB(0, 0), cB, voffB); PG8_STAGE(PG8_SB(0, 1), cB + hstep, voffB); PG8_STAGE(PG8_SA(0, 0), cA, voffA); PG8_STAGE(PG8_SA(0, 1), cA + hstep, voffA);
        if (wr == 1) PG8_BAR;
        PG8_WAIT_V(2); PG8_BAR;
        PG8_STAGE(PG8_SB(1, 0), cB + kstep, voffB); PG8_STAGE(PG8_SA(1, 0), cA + kstep, voffA); PG8_STAGE(PG8_SB(1, 1), cB + hstep + kstep, voffB);
        PG8_WAIT_V(6); PG8_BAR;
    } else {
        PG8_STAGE(PG8_SB(0, 0), cB, voffB); PG8_STAGE(PG8_SA(0, 0), cA, voffA); PG8_STAGE(PG8_SB(0, 1), cB + hstep, voffB); PG8_STAGE(PG8_SA(0, 1), cA + hstep, voffA);
        if (wr == 1) PG8_BAR;
        PG8_WAIT_V(4); PG8_BAR;
        PG8_STAGE(PG8_SB(1, 0), cB + kstep, voffB); PG8_STAGE(PG8_SA(1, 0), cA + kstep, voffA); PG8_STAGE(PG8_SB(1, 1), cB + hstep + kstep, voffB);
        PG8_WAIT_V(6); PG8_BAR;
    }
    for (;;) {
        const bool has_next = S.next(ui + 1, nxt);
        const char* nA = has_next ? (const char*)g.A + (size_t)nxt.pm * tstep : cA; const char* nB = has_next ? (const char*)g.Bt + (size_t)nxt.pn * tstep : cB;
        for (int t = 0; t < nt; t += 2) {
            const bool last = (t == nt - 2);
            const char* a1 = cA + (size_t)(t + 1) * kstep;
            const char* a2 = last ? nA : cA + (size_t)(t + 2) * kstep; const char* b2 = last ? nB : cB + (size_t)(t + 2) * kstep;
            const char* a3 = a2 + kstep; const char* b3 = b2 + kstep;
            if (last && has_next) S.a_ready(nxt);
            if constexpr (SP2) {
            PG8_LDB(B0, 0, 0); PG8_LDB(B1, 0, 1); PG8_SCHED; PG8_LDA(At, 0, 0); PG8_STAGE(PG8_SA(1, 1), a1 + hstep, voffA);
            PG8_WAIT_V(8); PG8_WAIT_L(0); PG8_BAR; PG8_MMA(0, 0, At, B0); PG8_MMA(0, 1, At, B1); PG8_BAR; PG8_SCHED;
            PG8_LDA(At, 0, 1); PG8_STAGE(PG8_SB(0, 0), b2, voffB); PG8_STAGE(PG8_SB(0, 1), b2 + hstep, voffB); PG8_STAGE(PG8_SA(0, 0), a2, voffA);
            PG8_WAIT_V(8); PG8_WAIT_L(0); PG8_BAR; PG8_MMA(1, 0, At, B0); PG8_MMA(1, 1, At, B1); PG8_BAR; PG8_SCHED;
            PG8_LDB(B0, 1, 0); PG8_LDB(B1, 1, 1); PG8_SCHED; PG8_LDA(At, 1, 0); PG8_STAGE(PG8_SA(0, 1), a2 + hstep, voffA);
            PG8_WAIT_V(8); PG8_WAIT_L(0); PG8_BAR; PG8_MMA(0, 0, At, B0); PG8_MMA(0, 1, At, B1); PG8_BAR; PG8_SCHED;
            PG8_LDA(At, 1, 1); PG8_STAGE(PG8_SB(1, 0), b3, voffB); PG8_STAGE(PG8_SB(1, 1), b3 + hstep, voffB); PG8_STAGE(PG8_SA(1, 0), a3, voffA);
            PG8_WAIT_V(8); PG8_WAIT_L(0); PG8_BAR; PG8_MMA(1, 0, At, B0); PG8_MMA(1, 1, At, B1); PG8_BAR; PG8_SCHED;
            } else {
            PG8_LDB(B0, 0, 0); PG8_SCHED; PG8_LDA(At, 0, 0); PG8_STAGE(PG8_SA(1, 1), a1 + hstep, voffA);
            PG8_WAIT_L(8); PG8_BAR; PG8_WAIT_L(0); PG8_MMA(0, 0, At, B0); PG8_BAR; PG8_SCHED;
            PG8_LDB(B1, 0, 1); PG8_STAGE(PG8_SB(0, 0), b2, voffB);
            PG8_BAR; PG8_WAIT_L(0); PG8_MMA(0, 1, At, B1); PG8_BAR;
            PG8_LDA(At, 0, 1); PG8_STAGE(PG8_SA(0, 0), a2, voffA);
            PG8_BAR; PG8_WAIT_L(0); PG8_MMA(1, 0, At, B0); PG8_BAR; PG8_SCHED;
            PG8_STAGE(PG8_SB(0, 1), b2 + hstep, voffB);
            PG8_WAIT_V(6); PG8_BAR; PG8_MMA(1, 1, At, B1); PG8_BAR;
            PG8_LDB(B0, 1, 0); PG8_SCHED; PG8_LDA(At, 1, 0); PG8_STAGE(PG8_SA(0, 1), a2 + hstep, voffA);
            PG8_WAIT_L(8); PG8_BAR; PG8_WAIT_L(0); PG8_MMA(0, 0, At, B0); PG8_BAR; PG8_SCHED;
            PG8_LDB(B1, 1, 1); PG8_STAGE(PG8_SB(1, 0), b3, voffB);
            PG8_BAR; PG8_WAIT_L(0); PG8_MMA(0, 1, At, B1); PG8_BAR;
            PG8_LDA(At, 1, 1); PG8_STAGE(PG8_SA(1, 0), a3, voffA);
            PG8_BAR; PG8_WAIT_L(0); PG8_MMA(1, 0, At, B0); PG8_BAR; PG8_SCHED;
            PG8_STAGE(PG8_SB(1, 1), b3 + hstep, voffB);
            PG8_WAIT_V(6); PG8_BAR; PG8_MMA(1, 1, At, B1); PG8_BAR;
            }
        }
        if constexpr (ALIGN_EPI) { if (wr == 0) PG8_BAR; }
        if constexpr (!Epi::AFTER_DRAIN) { E(acc, cur, wr, wc, fr, fq); S.done(cur); }
        if (!has_next) break;
#pragma unroll
        for (int a = 0; a < 2; ++a)
#pragma unroll
            for (int b = 0; b < 2; ++b)
#pragma unroll
                for (int m = 0; m < 4; ++m)
#pragma unroll
                    for (int n = 0; n < 2; ++n) acc[a][b][m][n] = (f32x4){0.f, 0.f, 0.f, 0.f};
        cur = nxt; cA = nA; cB = nB; ++ui;
        if constexpr (ALIGN_EPI) { if (wr == 1) PG8_BAR; }
    }
    PG8_WAIT_V(0);
    if constexpr (!ALIGN_EPI) { if (wr == 0) PG8_BAR; }
    PG8_BAR;
    if constexpr (Epi::AFTER_DRAIN) { E.fused(acc, cur, wr, wc, fr, fq, lds, wid, lane); S.done(cur); }
#undef PG8_SA
#undef PG8_SB
#undef PG8_STAGE
#undef PG8_LDA
#undef PG8_LDB
#undef PG8_MMA
#undef PG8_WAIT_V
#undef PG8_WAIT_L
#undef PG8_BAR
#undef PG8_SCHED
}
}

#define LAS __attribute__((address_space(3)))
typedef unsigned short bf16;
typedef float f32x4 __attribute__((ext_vector_type(4)));
typedef float f32x2 __attribute__((ext_vector_type(2)));
typedef short bf16x8 __attribute__((ext_vector_type(8)));
typedef short bf16x4 __attribute__((ext_vector_type(4)));
typedef unsigned u32x4 __attribute__((ext_vector_type(4)));
typedef unsigned u32x2 __attribute__((ext_vector_type(2)));

constexpr int NWAVES = 8, NTHREADS = 512;
constexpr int M = 16384, DM = 2048, FF = 5504, SEQ = 4096, NBATCH = 4, NH = 16, HD = 128;
constexpr float LN_EPS = 1e-5f;
constexpr int LDS_BYTES = 147456;
constexpr size_t SZ_WGU = (size_t)2 * FF * DM * 2, SZ_WD = (size_t)DM * FF * 2;
constexpr size_t WS_WGU = 0;
constexpr size_t WS_WD = WS_WGU + 4 * SZ_WGU;
constexpr size_t WS_WGLU = WS_WD + 4 * SZ_WD;
constexpr size_t WS_WQKV = WS_WGLU + (size_t)2 * DM * DM * 2;
constexpr size_t WS_WOUT = WS_WQKV + (size_t)3 * DM * DM * 2;
constexpr size_t WS_XB = WS_WOUT + (size_t)DM * DM * 2;
constexpr size_t WS_H = WS_XB + (size_t)M * DM * 2;
constexpr size_t WS_E = WS_H + (size_t)M * FF * 2;
constexpr size_t WS_END = WS_E + (size_t)M * DM * 4;
static_assert((size_t)M * DM * 4 <= (size_t)M * FF * 2, "Yf / Q|K fit in the h region");

__device__ __forceinline__ float wave_sum(float v) {
#pragma unroll
    for (int o = 1; o < 64; o <<= 1) v += __shfl_xor(v, o);
    return v;
}
__device__ __forceinline__ unsigned pk2(float lo, float hi) { return pg8::cvt_pk_bf16(lo, hi); }

__device__ __forceinline__ void conv_load(const float* __restrict__ W, int N, int item, int lane, f32x4 (&v)[8]) {
    const int nblk = N / 32, kb = item / nblk, nb = item % nblk;
    const float* p = W + (size_t)(64 * kb + 8 * (lane >> 3)) * N + 32 * nb + 4 * (lane & 7);
#pragma unroll
    for (int i = 0; i < 8; ++i) v[i] = __builtin_nontemporal_load((const f32x4*)(p + (size_t)i * N));
}
__device__ __forceinline__ void conv_store(bf16* __restrict__ WT, int K, int N, int mode, int item, int lane, const f32x4 (&v)[8]) {
    const int nblk = N / 32, kb = item / nblk, nb = item % nblk, n0 = 32 * nb;
    const int drow0 = (mode == 0) ? n0 : (256 * (n0 / 128) + (n0 % 128) + (mode == 2 ? 128 : 0));
    bf16* q = WT + (size_t)(drow0 + 4 * (lane & 7)) * K + 64 * kb + 8 * (lane >> 3);
#pragma unroll
    for (int e = 0; e < 4; ++e) { u32x4 o; o.x = pk2(v[0][e], v[1][e]); o.y = pk2(v[2][e], v[3][e]); o.z = pk2(v[4][e], v[5][e]); o.w = pk2(v[6][e], v[7][e]);
        *(u32x4*)(q + (size_t)e * K) = o; }
}
__device__ __forceinline__ void conv_matrix(const float* __restrict__ W, int K, int N, bf16* __restrict__ WT, int mode, int gw, int ngw, int lane) {
    const int nitems = (K / 64) * (N / 32);
    int it = gw;
    for (; it + ngw < nitems; it += 2 * ngw) {
        f32x4 v0[8], v1[8];
        conv_load(W, N, it, lane, v0); conv_load(W, N, it + ngw, lane, v1);
        conv_store(WT, K, N, mode, it, lane, v0); conv_store(WT, K, N, mode, it + ngw, lane, v1);
    }
    if (it < nitems) { f32x4 v0[8]; conv_load(W, N, it, lane, v0); conv_store(WT, K, N, mode, it, lane, v0); }
}

__device__ __forceinline__ void ln_phase(float* X, const float* g, const float* b, bf16* xb, int gw, int ngw, int lane) {
    for (int row = gw; row < M; row += ngw) {
        f32x4* xr = (f32x4*)(X + (size_t)row * DM) + lane;
        f32x4 v[8]; float s = 0.f;
#pragma unroll
        for (int j = 0; j < 8; ++j) { v[j] = xr[64 * j]; s += (v[j][0] + v[j][1]) + (v[j][2] + v[j][3]); }
        const float mean = wave_sum(s) * (1.f / DM); float s2 = 0.f;
#pragma unroll
        for (int j = 0; j < 8; ++j) { v[j] = v[j] - mean; s2 += (v[j][0] * v[j][0] + v[j][1] * v[j][1]) + (v[j][2] * v[j][2] + v[j][3] * v[j][3]); }
        const float rstd = 1.f / sqrtf(wave_sum(s2) * (1.f / DM) + LN_EPS);
        u32x2* o8 = (u32x2*)(xb + (size_t)row * DM) + lane;
#pragma unroll
        for (int j = 0; j < 8; ++j) { const f32x4 gv = ((const f32x4*)g)[lane + 64 * j], bv = ((const f32x4*)b)[lane + 64 * j];
            const f32x4 y = v[j] * rstd * gv + bv; xr[64 * j] = y;
            u32x2 w; w.x = pk2(y[0], y[1]); w.y = pk2(y[2], y[3]); o8[64 * j] = w; }
    }
}

__device__ __forceinline__ void s5_phase(const bf16* xb, const float* lam_re, const float* lam_im, const float* log_dt, const float* b_re, const float* b_im,
                                         const float* c_re, const float* c_im, float* Yf, float* Yb, LAS unsigned char* lds, int wave, int lane) {
    LAS float* BU = (LAS float*)(lds + wave * 25600);
    LAS unsigned* SS = (LAS unsigned*)(lds + wave * 25600 + 16896);
    const int n = lane & 15, g4 = lane >> 4;
    for (int task = blockIdx.x * 4 + wave; task < 1024; task += gridDim.x * 4) {
        const int dir = task & 1, g = (task >> 1) & 127, b = task >> 8, dg = dir * 128 + g;
        const float dt = expf(log_dt[dg]);
        float lbr, lbi;
        { const float lr = fminf(lam_re[dg * 64 + lane], -1e-4f), li = lam_im[dg * 64 + lane]; const float mag = expf(lr * dt); lbr = mag * cosf(li * dt); lbi = mag * sinf(li * dt); }
        bf16x4 Bf[8];
#pragma unroll
        for (int nt = 0; nt < 8; ++nt) {
            const int p = 8 * nt + (n >> 1), part = n & 1;
            const float lr = fminf(lam_re[dg * 64 + p], -1e-4f), li = lam_im[dg * 64 + p]; const float mag = expf(lr * dt);
            const float pr = mag * cosf(li * dt), pi = mag * sinf(li * dt), den = lr * lr + li * li, nr = pr - 1.0f, ni = pi;
            const float fre = (nr * lr + ni * li) / den, fim = (ni * lr - nr * li) / den;
            const f32x4 br = *(const f32x4*)(b_re + ((size_t)dg * 64 + p) * 16 + 4 * g4), bi = *(const f32x4*)(b_im + ((size_t)dg * 64 + p) * 16 + 4 * g4);
            const f32x4 v = part == 0 ? (br * fre - bi * fim) : (bi * fre + br * fim);
            const unsigned w0 = pk2(v[0], v[1]), w1 = pk2(v[2], v[3]);
            Bf[nt] = __builtin_bit_cast(bf16x4, (u32x2){w0, w1});
        }
        bf16x8 Cf[4];
#pragma unroll
        for (int kc = 0; kc < 4; ++kc) {
            float cv[8];
#pragma unroll
            for (int e = 0; e < 8; ++e) { const int p = 16 * kc + 4 * g4 + (e >> 1); const size_t ci = ((size_t)dg * 16 + n) * 64 + p; cv[e] = (e & 1) ? -c_im[ci] : c_re[ci]; }
            Cf[kc] = __builtin_bit_cast(bf16x8, (u32x4){pk2(cv[0], cv[1]), pk2(cv[2], cv[3]), pk2(cv[4], cv[5]), pk2(cv[6], cv[7])});
        }
        float s_re = 0.f, s_im = 0.f;
        const bf16* xrow = xb + (size_t)b * SEQ * DM + g * 16 + 4 * g4;
        float* Y = (dir ? Yb : Yf) + (size_t)b * SEQ * DM + g * 16 + n;
        int t0 = dir ? SEQ - 32 : 0;
        u32x2 a0 = *(const u32x2*)(xrow + (size_t)(t0 + n) * DM), a1 = *(const u32x2*)(xrow + (size_t)(t0 + 16 + n) * DM);
        for (int ci = 0; ci < SEQ / 32; ++ci) {
            t0 = dir ? SEQ - 32 * (ci + 1) : 32 * ci;
            const bf16x4 A0 = __builtin_bit_cast(bf16x4, a0), A1 = __builtin_bit_cast(bf16x4, a1);
            if (ci + 1 < SEQ / 32) { const int tn = dir ? t0 - 32 : t0 + 32; a0 = *(const u32x2*)(xrow + (size_t)(tn + n) * DM); a1 = *(const u32x2*)(xrow + (size_t)(tn + 16 + n) * DM); }
#pragma unroll
            for (int nt = 0; nt < 8; ++nt) {
                const f32x4 z = {0.f, 0.f, 0.f, 0.f};
                const f32x4 d0 = __builtin_amdgcn_mfma_f32_16x16x16bf16_1k(A0, Bf[nt], z, 0, 0, 0);
                const f32x4 d1 = __builtin_amdgcn_mfma_f32_16x16x16bf16_1k(A1, Bf[nt], z, 0, 0, 0);
#pragma unroll
                for (int j = 0; j < 4; ++j) { BU[(4 * g4 + j) * 132 + 16 * nt + n] = d0[j]; BU[(16 + 4 * g4 + j) * 132 + 16 * nt + n] = d1[j]; }
            }
            f32x2 buv[32];
#pragma unroll
            for (int step = 0; step < 32; ++step) { const int t = dir ? 31 - step : step; buv[step] = *(const LAS f32x2*)(BU + t * 132 + 2 * lane); }
#pragma unroll
            for (int step = 0; step < 32; ++step) {
                const int t = dir ? 31 - step : step;
                const float nr = __builtin_fmaf(lbr, s_re, __builtin_fmaf(-lbi, s_im, buv[step][0]));
                const float ni = __builtin_fmaf(lbr, s_im, __builtin_fmaf(lbi, s_re, buv[step][1]));
                s_re = nr; s_im = ni;
                SS[t * 68 + lane] = pk2(nr, ni);
            }
#pragma unroll
            for (int tt = 0; tt < 2; ++tt) {
                f32x4 acc = {0.f, 0.f, 0.f, 0.f};
#pragma unroll
                for (int kc = 0; kc < 4; ++kc) { const bf16x8 A = *(const LAS bf16x8*)(SS + (16 * tt + n) * 68 + 16 * kc + 4 * g4); acc = __builtin_amdgcn_mfma_f32_16x16x32_bf16(A, Cf[kc], acc, 0, 0, 0); }
#pragma unroll
                for (int j = 0; j < 4; ++j) Y[(size_t)(t0 + 16 * tt + 4 * g4 + j) * DM] = acc[j];
            }
        }
    }
}

#define NA_BAR() do { asm volatile("s_waitcnt lgkmcnt(0)" ::: "memory"); __builtin_amdgcn_s_barrier(); asm volatile("" ::: "memory"); } while (0)
__device__ __forceinline__ void natten_phase(const bf16* Q, const bf16* K, const bf16* VT, bf16* O, const float* rpb, LAS unsigned char* lds, int tid, int wave, int lane) {
    constexpr int BUF = 36864, KH = 17408, VH = 18432;
    LAS float* RP = (LAS float*)(lds + 2 * BUF + 1024);
    for (int i = tid; i < 16 * 465; i += NTHREADS) RP[i] = rpb[i];
    const int n = lane & 15, g4 = lane >> 4, hsel = wave >> 2, cg_ = wave & 3;
    const int nunits = NBATCH * 64 * 8, per = (nunits + gridDim.x - 1) / gridDim.x;
    int ksrc[4], kdst[4], vsrc[4], vdst[4];
#pragma unroll
    for (int q = 0; q < 4; ++q) { const int idx = tid + NTHREADS * q;
        ksrc[q] = ((idx >> 4) & 63) * DM + (idx >> 10) * HD + (idx & 15) * 8; kdst[q] = (idx >> 10) * KH + ((idx >> 4) & 63) * 272 + (idx & 15) * 16;
        vsrc[q] = ((idx >> 10) * HD + ((idx >> 3) & 127)) * M + (idx & 7) * 8; vdst[q] = (idx >> 10) * VH + ((idx >> 3) & 127) * 144 + (idx & 7) * 16; }
    NA_BAR();
    for (int it = 0; it < per; ++it) {
        const int unit = blockIdx.x * per + it; if (unit >= nunits) break;
        const int r = unit & 63, hp = (unit >> 6) & 7, b = unit >> 9, h = 2 * hp + hsel;
        const int rs = min(max(r - 4, 0), 56), cbase = min(max(16 * cg_ - 8, 0), 32);
        const size_t tokb = (size_t)b * SEQ;
        const bf16* Kg = K + (tokb + rs * 64) * DM + 2 * hp * HD;
        const bf16* Vg = VT + (size_t)(2 * hp * HD) * M + tokb + rs * 64;
        u32x4 pre[3][4];
#define NA_LOAD(st) do { if ((st) < 8) { _Pragma("unroll") for (int q = 0; q < 4; ++q) pre[(st) % 3][q] = *(const u32x4*)(Kg + (size_t)(st) * 64 * DM + ksrc[q]); } \
                         else { _Pragma("unroll") for (int q = 0; q < 4; ++q) pre[(st) % 3][q] = *(const u32x4*)(Vg + ((st) - 8) * 64 + vsrc[q]); } } while (0)
#define NA_WRITE(st) do { LAS unsigned char* wb = lds + ((st) & 1) * BUF; if ((st) < 8) { _Pragma("unroll") for (int q = 0; q < 4; ++q) *(LAS u32x4*)(wb + kdst[q]) = pre[(st) % 3][q]; } \
                          else { _Pragma("unroll") for (int q = 0; q < 4; ++q) *(LAS u32x4*)(wb + vdst[q]) = pre[(st) % 3][q]; } } while (0)
        NA_LOAD(0); NA_LOAD(1);
        const bf16* qp = Q + (tokb + r * 64 + cg_ * 16 + n) * DM + h * HD + 8 * g4;
        bf16x8 qf[4];
#pragma unroll
        for (int kc = 0; kc < 4; ++kc) qf[kc] = *(const bf16x8*)(qp + 32 * kc);
        NA_WRITE(0); NA_BAR(); NA_LOAD(2);
        f32x4 s[16]; f32x4 o[8]; float inv = 1.f;
#pragma unroll
        for (int mt = 0; mt < 8; ++mt) o[mt] = (f32x4){0.f, 0.f, 0.f, 0.f};
#pragma unroll
        for (int st = 0; st < 16; ++st) {
            const LAS unsigned char* rb = lds + (st & 1) * BUF;
            if (st < 8) {
#pragma unroll
                for (int half = 0; half < 2; ++half) {
                    const LAS unsigned char* kp = rb + hsel * KH + (cbase + 16 * half + n) * 272 + 16 * g4;
                    f32x4 acc = {0.f, 0.f, 0.f, 0.f};
#pragma unroll
                    for (int kc = 0; kc < 4; ++kc) { const bf16x8 kf = *(const LAS bf16x8*)(kp + 64 * kc); acc = __builtin_amdgcn_mfma_f32_16x16x32_bf16(kf, qf[kc], acc, 0, 0, 0); }
                    s[2 * st + half] = acc;
                }
            } else {
                if (st == 8) {
                    const int c = 16 * cg_ + n, cs = min(max(c - 8, 0), 48);
                    const LAS float* rph = RP + h * 465;
                    float mx = -1e30f;
#pragma unroll
                    for (int j = 0; j < 16; ++j) {
                        const int rowoff = rs + (j >> 1) - r + 7;
#pragma unroll
                        for (int e = 0; e < 4; ++e) {
                            const int kcol = cbase + 16 * (j & 1) + 4 * g4 + e; const bool valid = (kcol >= cs) && (kcol < cs + 16);
                            const int coff = min(max(kcol - c + 15, 0), 30);
                            const float v = valid ? s[j][e] + rph[rowoff * 31 + coff] : -1e30f;
                            s[j][e] = v; mx = fmaxf(mx, v);
                        }
                    }
                    mx = fmaxf(mx, __shfl_xor(mx, 16)); mx = fmaxf(mx, __shfl_xor(mx, 32));
                    float sum = 0.f;
#pragma unroll
                    for (int j = 0; j < 16; ++j)
#pragma unroll
                        for (int e = 0; e < 4; ++e) { const float p = __expf(s[j][e] - mx); s[j][e] = p; sum += p; }
                    sum += __shfl_xor(sum, 16); sum += __shfl_xor(sum, 32);
                    inv = 1.0f / sum;
                }
                const int jj = st - 8;
                const bf16x8 pf = __builtin_bit_cast(bf16x8, (u32x4){pk2(s[2 * jj][0], s[2 * jj][1]), pk2(s[2 * jj][2], s[2 * jj][3]), pk2(s[2 * jj + 1][0], s[2 * jj + 1][1]), pk2(s[2 * jj + 1][2], s[2 * jj + 1][3])});
                const LAS unsigned char* vp = rb + hsel * VH + n * 144 + (cbase + 4 * g4) * 2;
#pragma unroll
                for (int mt = 0; mt < 8; ++mt) {
                    const u32x2 lo = *(const LAS u32x2*)(vp + mt * 16 * 144), hi = *(const LAS u32x2*)(vp + mt * 16 * 144 + 32);
                    const bf16x8 vf = __builtin_bit_cast(bf16x8, (u32x4){lo.x, lo.y, hi.x, hi.y});
                    o[mt] = __builtin_amdgcn_mfma_f32_16x16x32_bf16(vf, pf, o[mt], 0, 0, 0);
                }
            }
            if (st + 1 < 16) NA_WRITE(st + 1);
            NA_BAR();
            if (st + 3 < 16) NA_LOAD(st + 3);
        }
        bf16* op = O + (tokb + r * 64 + cg_ * 16 + n) * DM + h * HD + 4 * g4;
#pragma unroll
        for (int mt = 0; mt < 8; ++mt) { u32x2 w; w.x = pk2(o[mt][0] * inv, o[mt][1] * inv); w.y = pk2(o[mt][2] * inv, o[mt][3] * inv); *(u32x2*)(op + 16 * mt) = w; }
#undef NA_LOAD
#undef NA_WRITE
    }
}

struct Args { const float* in[19]; float* out; unsigned char* ws; int ph_lo, ph_hi; };
constexpr int N_PHASES = 21;
#ifndef DIS_S5
#define DIS_S5 0
#endif
#ifndef DIS_ATT
#define DIS_ATT 0
#endif
#ifndef DIS_GEMM
#define DIS_GEMM 0
#endif
#ifndef GEMM_MASK
#define GEMM_MASK 0xff
#endif
#ifndef REP_S5
#define REP_S5 1
#endif
#ifndef REP_ATT
#define REP_ATT 1
#endif
#ifndef REP_P0
#define REP_P0 1
#endif
#ifndef MK_PER_PHASE
#define MK_PER_PHASE 0
#endif

__global__ void __launch_bounds__(NTHREADS, 2) mega_fwd(Args args) {
    extern __shared__ __attribute__((aligned(16))) unsigned char lds_raw[];
    LAS unsigned char* lds = (LAS unsigned char*)lds_raw;
    const int tid = threadIdx.x, lane = tid & 63, wave = __builtin_amdgcn_readfirstlane(tid >> 6);
    const int G = gridDim.x, gw = blockIdx.x * NWAVES + wave, ngw = G * NWAVES;
    unsigned char* ws = args.ws;
    const float* x_in = args.in[0];
    float* out = args.out;
    bf16* Wgu = (bf16*)(ws + WS_WGU); bf16* Wd = (bf16*)(ws + WS_WD); bf16* Wglu = (bf16*)(ws + WS_WGLU); bf16* Wqkv = (bf16*)(ws + WS_WQKV); bf16* Wout = (bf16*)(ws + WS_WOUT);
    bf16* XB = (bf16*)(ws + WS_XB); bf16* HB = (bf16*)(ws + WS_H);
    float* Yf = (float*)(ws + WS_H); float* Yb = (float*)(ws + WS_E);
    bf16* Qb = (bf16*)(ws + WS_H); bf16* Kb = Qb + (size_t)M * DM; bf16* VT = (bf16*)(ws + WS_E); bf16* Ob = VT + (size_t)M * DM;
    const int lo = args.ph_lo, hi = args.ph_hi;
    int pid = 0;
#define RUN() (lo <= pid && pid < hi)
#if MK_PER_PHASE
#define END_PHASE() do { ++pid; } while (0)
#else
#define END_PHASE() do { if (lo <= pid && pid + 1 < hi) cg::this_grid().sync(); ++pid; } while (0)
#endif

    if (RUN()) for (int rep_ = 0; rep_ < REP_P0; ++rep_) {
        conv_matrix(args.in[1], DM, FF, Wgu, 1, gw, ngw, lane);
        conv_matrix(args.in[2], DM, FF, Wgu, 2, gw, ngw, lane);
        conv_matrix(args.in[3], FF, DM, Wd, 0, gw, ngw, lane);
        conv_matrix(args.in[14], DM, DM, Wglu, 1, gw, ngw, lane);
        conv_matrix(args.in[15], DM, DM, Wglu, 2, gw, ngw, lane);
        for (size_t i = (size_t)blockIdx.x * NTHREADS + tid; i < (size_t)M * DM / 8; i += (size_t)G * NTHREADS) {
            const f32x4 v0 = ((const f32x4*)x_in)[2 * i], v1 = ((const f32x4*)x_in)[2 * i + 1];
            u32x4 w; w.x = pk2(v0[0], v0[1]); w.y = pk2(v0[2], v0[3]); w.z = pk2(v1[0], v1[1]); w.w = pk2(v1[2], v1[3]);
            ((u32x4*)XB)[i] = w;
        }
    }
    END_PHASE();

    {
        if (RUN()) {
            pg8::Gemm g{XB, Wgu + (size_t)0 * 2 * FF * DM, M, 2 * FF, DM}; pg8::StaticOrder S; S.init(M, 2 * FF, G, (int)blockIdx.x);
            pg8::EpiSwiGLU E{HB, FF};
            if (!DIS_GEMM && ((GEMM_MASK >> 0) & 1)) pg8::gemm_phase<pg8::EpiSwiGLU, pg8::StaticOrder, true, true>(lds, g, S, E);
        }
        END_PHASE();
        if (RUN()) {
            pg8::Gemm g{HB, Wd + (size_t)0 * DM * FF, M, DM, FF}; pg8::StaticOrder S; S.init(M, DM, G, (int)blockIdx.x);
            pg8::EpiResid E{x_in, out, 0.5f};
            if (!DIS_GEMM && ((GEMM_MASK >> 1) & 1)) pg8::gemm_phase<pg8::EpiResid, pg8::StaticOrder, true, true>(lds, g, S, E);
        }
        END_PHASE();
        if (RUN()) { const int li = 0; ln_phase(out, args.in[4] + li * DM, args.in[5] + li * DM, XB, gw, ngw, lane); }
        END_PHASE();

    }
    {
            if (RUN()) {
                if (wave < 4) s5_phase(XB, args.in[6], args.in[7], args.in[8], args.in[9], args.in[10], args.in[11], args.in[12], Yf, Yb, lds, wave, lane);
                else {
                    const int gw4 = blockIdx.x * 4 + (wave - 4), ngw4 = G * 4;
#pragma unroll 1
                    for (int f = 1; f < 4; ++f) {
                        conv_matrix(args.in[1] + (size_t)f * DM * FF, DM, FF, Wgu + (size_t)f * 2 * FF * DM, 1, gw4, ngw4, lane);
                        conv_matrix(args.in[2] + (size_t)f * DM * FF, DM, FF, Wgu + (size_t)f * 2 * FF * DM, 2, gw4, ngw4, lane);
                        conv_matrix(args.in[3] + (size_t)f * FF * DM, FF, DM, Wd + (size_t)f * DM * FF, 0, gw4, ngw4, lane);
                    }
                    conv_matrix(args.in[16], DM, 3 * DM, Wqkv, 0, gw4, ngw4, lane);
                    conv_matrix(args.in[18], DM, DM, Wout, 0, gw4, ngw4, lane);
                }
            }
            END_PHASE();
            if (RUN()) {
                const float* dsk = args.in[13];
                for (size_t i = (size_t)blockIdx.x * NTHREADS + tid; i < (size_t)M * DM / 4; i += (size_t)G * NTHREADS) {
                    const f32x4 a = ((const f32x4*)Yf)[i], bb = ((const f32x4*)Yb)[i], xv = ((const f32x4*)out)[i], dv = ((const f32x4*)dsk)[i & (DM / 4 - 1)];
                    const f32x4 y = a + bb + dv * xv; float gq[4];
#pragma unroll
                    for (int e = 0; e < 4; ++e) { const float t = y[e], z = 1.5957691216057308f * (t + 0.044715f * t * t * t); gq[e] = t * pg8::fast_sigmoid(z); }
                    u32x2 w; w.x = pk2(gq[0], gq[1]); w.y = pk2(gq[2], gq[3]); ((u32x2*)XB)[i] = w;
                }
            }
            END_PHASE();
            if (RUN()) {
                pg8::Gemm g{XB, Wglu, M, 2 * DM, DM}; pg8::StaticOrder S; S.init(M, 2 * DM, G, (int)blockIdx.x);
                pg8::EpiGLU E{out, out};
                if (!DIS_GEMM && ((GEMM_MASK >> 2) & 1)) pg8::gemm_phase<pg8::EpiGLU, pg8::StaticOrder, true, true>(lds, g, S, E);
            }
            END_PHASE();
            if (RUN()) ln_phase(out, args.in[4] + 1 * DM, args.in[5] + 1 * DM, XB, gw, ngw, lane);
            END_PHASE();
            }
    {
        if (RUN()) {
            pg8::Gemm g{XB, Wgu + (size_t)1 * 2 * FF * DM, M, 2 * FF, DM}; pg8::StaticOrder S; S.init(M, 2 * FF, G, (int)blockIdx.x);
            pg8::EpiSwiGLU E{HB, FF};
            if (!DIS_GEMM && ((GEMM_MASK >> 0) & 1)) pg8::gemm_phase<pg8::EpiSwiGLU, pg8::StaticOrder, true, true>(lds, g, S, E);
        }
        END_PHASE();
        if (RUN()) {
            pg8::Gemm g{HB, Wd + (size_t)1 * DM * FF, M, DM, FF}; pg8::StaticOrder S; S.init(M, DM, G, (int)blockIdx.x);
            pg8::EpiResid E{out, out, 0.5f};
            if (!DIS_GEMM && ((GEMM_MASK >> 1) & 1)) pg8::gemm_phase<pg8::EpiResid, pg8::StaticOrder, true, true>(lds, g, S, E);
        }
        END_PHASE();
        if (RUN()) { const int li = 2; ln_phase(out, args.in[4] + li * DM, args.in[5] + li * DM, XB, gw, ngw, lane); }
        END_PHASE();

    }
    {
        if (RUN()) {
            pg8::Gemm g{XB, Wgu + (size_t)2 * 2 * FF * DM, M, 2 * FF, DM}; pg8::StaticOrder S; S.init(M, 2 * FF, G, (int)blockIdx.x);
            pg8::EpiSwiGLU E{HB, FF};
            if (!DIS_GEMM && ((GEMM_MASK >> 0) & 1)) pg8::gemm_phase<pg8::EpiSwiGLU, pg8::StaticOrder, true, true>(lds, g, S, E);
        }
        END_PHASE();
        if (RUN()) {
            pg8::Gemm g{HB, Wd + (size_t)2 * DM * FF, M, DM, FF}; pg8::StaticOrder S; S.init(M, DM, G, (int)blockIdx.x);
            pg8::EpiResid E{out, out, 0.5f};
            if (!DIS_GEMM && ((GEMM_MASK >> 1) & 1)) pg8::gemm_phase<pg8::EpiResid, pg8::StaticOrder, true, true>(lds, g, S, E);
        }
        END_PHASE();
        if (RUN()) { const int li = 3; ln_phase(out, args.in[4] + li * DM, args.in[5] + li * DM, XB, gw, ngw, lane); }
        END_PHASE();

    }
    {
            if (RUN()) {
                { pg8::Gemm g{XB, Wqkv, M, 2 * DM, DM}; pg8::StaticOrder S; S.init(M, 2 * DM, G, (int)blockIdx.x);
                  pg8::EpiQK E{Qb, Kb, 0.08838834764831845f};
                  if (!DIS_GEMM && ((GEMM_MASK >> 3) & 1)) pg8::gemm_phase<pg8::EpiQK, pg8::StaticOrder, true, true>(lds, g, S, E); }
                { pg8::Gemm g{XB, Wqkv + (size_t)2 * DM * DM, M, DM, DM}; pg8::StaticOrder S; S.init(M, DM, G, (int)blockIdx.x);
                  pg8::EpiVT E{VT};
                  if (!DIS_GEMM && ((GEMM_MASK >> 4) & 1)) pg8::gemm_phase<pg8::EpiVT, pg8::StaticOrder, true, true>(lds, g, S, E); }
            }
            END_PHASE();
            if (RUN() && !DIS_ATT) natten_phase(Qb, Kb, VT, Ob, args.in[17], lds, tid, wave, lane);
            END_PHASE();
            if (RUN()) {
                pg8::Gemm g{Ob, Wout, M, DM, DM}; pg8::StaticOrder S; S.init(M, DM, G, (int)blockIdx.x);
                pg8::EpiResid E{out, out, 1.0f};
                if (!DIS_GEMM && ((GEMM_MASK >> 5) & 1)) pg8::gemm_phase<pg8::EpiResid, pg8::StaticOrder, true, true>(lds, g, S, E);
            }
            END_PHASE();
            if (RUN()) ln_phase(out, args.in[4] + 4 * DM, args.in[5] + 4 * DM, XB, gw, ngw, lane);
            END_PHASE();
            }
    {
        if (RUN()) {
            pg8::Gemm g{XB, Wgu + (size_t)3 * 2 * FF * DM, M, 2 * FF, DM}; pg8::StaticOrder S; S.init(M, 2 * FF, G, (int)blockIdx.x);
            pg8::EpiSwiGLU E{HB, FF};
            if (!DIS_GEMM && ((GEMM_MASK >> 0) & 1)) pg8::gemm_phase<pg8::EpiSwiGLU, pg8::StaticOrder, true, true>(lds, g, S, E);
        }
        END_PHASE();
        if (RUN()) {
            pg8::Gemm g{HB, Wd + (size_t)3 * DM * FF, M, DM, FF}; pg8::StaticOrder S; S.init(M, DM, G, (int)blockIdx.x);
            pg8::EpiResid E{out, out, 0.5f};
            if (!DIS_GEMM && ((GEMM_MASK >> 1) & 1)) pg8::gemm_phase<pg8::EpiResid, pg8::StaticOrder, true, true>(lds, g, S, E);
        }
        END_PHASE();
        if (RUN()) { const int li = 5; ln_phase(out, args.in[4] + li * DM, args.in[5] + li * DM, XB, gw, ngw, lane); }
        END_PHASE();

    }
#undef RUN
#undef END_PHASE
}

extern "C" void kernel_launch(void* const* d_in, const int* in_sizes, int n_in, void* d_out, int out_size, void* d_ws, size_t ws_size, hipStream_t stream) {
    static int grid = 0;
    if (grid == 0) {
        if (n_in != 19 || in_sizes[0] != M * DM || out_size != M * DM || ws_size < WS_END) { fprintf(stderr, "kernel_launch: unexpected shapes / workspace (n_in %d, ws %zu < %zu)\n", n_in, ws_size, (size_t)WS_END); grid = -1; return; }
        int dev = 0, cus = 0, per_cu = 0;
        if (hipGetDevice(&dev) != hipSuccess || hipDeviceGetAttribute(&cus, hipDeviceAttributeMultiprocessorCount, dev) != hipSuccess) { grid = -1; return; }
        if (hipFuncSetAttribute((const void*)mega_fwd, hipFuncAttributeMaxDynamicSharedMemorySize, LDS_BYTES) != hipSuccess) { fprintf(stderr, "kernel_launch: hipFuncSetAttribute failed\n"); grid = -1; return; }
        if (hipOccupancyMaxActiveBlocksPerMultiprocessor(&per_cu, (const void*)mega_fwd, NTHREADS, LDS_BYTES) != hipSuccess || per_cu < 1) { fprintf(stderr, "kernel_launch: occupancy query says %d\n", per_cu); per_cu = 1; }
        (void)hipGetLastError();
        grid = cus * per_cu;
    }
    if (grid < 0) return;
    Args a{};
    for (int i = 0; i < 19; ++i) a.in[i] = (const float*)d_in[i];
    a.out = (float*)d_out; a.ws = (unsigned char*)d_ws;
#if MK_PER_PHASE
    for (int p = 0; p < N_PHASES; ++p) { a.ph_lo = p; a.ph_hi = p + 1; hipLaunchKernelGGL(mega_fwd, dim3(grid), dim3(NTHREADS), LDS_BYTES, stream, a); }
#else
    a.ph_lo = 0; a.ph_hi = N_PHASES;
    void* kargs[] = {&a};
    hipError_t e = hipLaunchCooperativeKernel((const void*)mega_fwd, dim3(grid), dim3(NTHREADS), kargs, LDS_BYTES, stream);
    if (e != hipSuccess) fprintf(stderr, "kernel_launch: cooperative launch failed: %s (grid %d)\n", hipGetErrorString(e), grid);
#endif
}
```
